# Optimizing an MI355X kernel written in HIP

```python
import jax, jax.numpy as jnp
from jax import lax
import numpy as np

D_MODEL = 1024
BATCH = 8
SEQ = 4096
DEPTH = 1

CHUNK = 64
Q_BLOCK = 128
MLA_HEADS = 8
QK_NOPE_DIM = 64
QK_ROPE_DIM = 32
QK_HEAD_DIM = QK_NOPE_DIM + QK_ROPE_DIM
V_HEAD_DIM = 64
Q_LORA_RANK = 384
KV_LORA_RANK = 128
ROPE_THETA = 10000.0
ATTN_WIDTH = MLA_HEADS * V_HEAD_DIM
CONV_WIDTH = D_MODEL - ATTN_WIDTH
CONV_KERNEL = 31
IN_WIDTH = Q_LORA_RANK + KV_LORA_RANK + QK_ROPE_DIM + 2 * CONV_WIDTH
N_EXPERTS = 32
TOP_K = 4
D_FF = D_MODEL
SWIGLU_ALPHA = 1.702
SWIGLU_LIMIT = 7.0
MOE_BLOCK = 256
EPS = 1e-6

kernel_name = "hybrid_mla_conformer_moe_block"


def rms_norm(x, g):
    xf = x.astype(jnp.float32)
    y = xf * lax.rsqrt(jnp.mean(xf * xf, axis=-1, keepdims=True) + EPS)
    return (y * g.astype(jnp.float32)).astype(x.dtype)


def layer_norm(x, g, b):
    xf = x.astype(jnp.float32)
    mu = jnp.mean(xf, axis=-1, keepdims=True)
    xc = xf - mu
    y = xc * lax.rsqrt(jnp.mean(xc * xc, axis=-1, keepdims=True) + EPS)
    return (y * g.astype(jnp.float32) + b.astype(jnp.float32)).astype(x.dtype)


def rope_tables(positions):
    inv_freq = 1.0 / (ROPE_THETA ** (jnp.arange(0, QK_ROPE_DIM, 2, dtype=jnp.float32) / QK_ROPE_DIM))
    ang = positions.astype(jnp.float32)[..., None] * inv_freq
    return jnp.cos(ang)[:, :, None, :], jnp.sin(ang)[:, :, None, :]


def rope_tail(t, cos, sin):
    nope, pe = t[..., :QK_NOPE_DIM], t[..., QK_NOPE_DIM:].astype(jnp.float32)
    half = QK_ROPE_DIM // 2
    x1, x2 = pe[..., :half], pe[..., half:]
    rot = jnp.concatenate([x1 * cos - x2 * sin, x2 * cos + x1 * sin], axis=-1)
    return jnp.concatenate([nope, rot.astype(t.dtype)], axis=-1)


def attend_block(qb, kb, vb, q0):
    scale = QK_HEAD_DIM ** -0.5
    s = jnp.einsum('bqhd,bkhd->bhqk', qb, kb, preferred_element_type=jnp.float32) * scale
    q_chunk = (q0 + jnp.arange(qb.shape[1])) // CHUNK
    k_chunk = jnp.arange(kb.shape[1]) // CHUNK
    s = jnp.where(k_chunk[None, :] <= q_chunk[:, None], s, -jnp.inf)
    p = jax.nn.softmax(s, axis=-1).astype(vb.dtype)
    return jnp.einsum('bhqk,bkhd->bqhd', p, vb)


def mla(c_q, c_kv, k_pe, cos, sin, q_latent_g, w_uq, kv_latent_g, w_ukv, q_head_g, k_head_g):
    B, S, _ = c_q.shape
    q = (rms_norm(c_q, q_latent_g) @ w_uq).reshape(B, S, MLA_HEADS, QK_HEAD_DIM)
    kv = (rms_norm(c_kv, kv_latent_g) @ w_ukv).reshape(B, S, MLA_HEADS, QK_NOPE_DIM + V_HEAD_DIM)
    k_nope, v = kv[..., :QK_NOPE_DIM], kv[..., QK_NOPE_DIM:]
    k = jnp.concatenate(
        [k_nope, jnp.broadcast_to(k_pe[:, :, None, :], (B, S, MLA_HEADS, QK_ROPE_DIM))], axis=-1)
    q = rope_tail(rms_norm(q, q_head_g), cos, sin)
    k = rope_tail(rms_norm(k, k_head_g), cos, sin)
    outs = []
    for i in range(S // Q_BLOCK):
        q0, end = i * Q_BLOCK, (i + 1) * Q_BLOCK
        outs.append(attend_block(q[:, q0:end], k[:, :end], v[:, :end], q0))
    return jnp.concatenate(outs, axis=1).reshape(B, S, ATTN_WIDTH)


def conformer_conv(u, dw_w, dw_b, ln_g, ln_b):
    a, g = u[..., :CONV_WIDTH], u[..., CONV_WIDTH:]
    y = a * jax.nn.sigmoid(g)
    y = lax.conv_general_dilated(
        y, dw_w[:, None, :].astype(y.dtype), window_strides=(1,),
        padding=[(CONV_KERNEL - 1, 0)], dimension_numbers=('NWC', 'WIO', 'NWC'),
        feature_group_count=CONV_WIDTH) + dw_b
    return jax.nn.silu(layer_norm(y, ln_g, ln_b))


def moe(h, router_w, router_b, w_gate_up, b_gate_up, w_down, b_down):
    B, S, D = h.shape
    T = B * S
    hf = h.reshape(T, D)
    logits = (hf @ router_w).astype(jnp.float32) + router_b.astype(jnp.float32)
    top_val, top_idx = lax.top_k(logits, TOP_K)
    gates = jax.nn.softmax(top_val, axis=-1)
    n_assign = T * TOP_K
    flat_e = top_idx.reshape(-1).astype(jnp.int32)
    flat_tok = jnp.arange(n_assign, dtype=jnp.int32) // TOP_K
    order = jnp.argsort(flat_e)
    se, stok, sw = flat_e[order], flat_tok[order], gates.reshape(-1)[order]
    counts = jnp.bincount(flat_e, length=N_EXPERTS)
    starts = jnp.cumsum(counts) - counts
    pcounts = (counts + MOE_BLOCK - 1) // MOE_BLOCK * MOE_BLOCK
    pends = jnp.cumsum(pcounts)
    pstarts = pends - pcounts
    dest = pstarts[se] + jnp.arange(n_assign, dtype=jnp.int32) - starts[se]
    P = n_assign + N_EXPERTS * MOE_BLOCK
    n_blocks = P // MOE_BLOCK
    slot_tok = jnp.full((P,), T, jnp.int32).at[dest].set(stok)
    slot_w = jnp.zeros((P,), jnp.float32).at[dest].set(sw)
    block_e = jnp.minimum(
        jnp.searchsorted(pends, jnp.arange(n_blocks) * MOE_BLOCK, side='right'), N_EXPERTS - 1)
    x_pad = jnp.concatenate([hf, jnp.zeros((1, D), hf.dtype)], axis=0)
    xs = x_pad[slot_tok].reshape(n_blocks, MOE_BLOCK, D)

    def expert_block(args):
        xb, e = args
        gu = xb @ w_gate_up[e] + b_gate_up[e]
        gate = jnp.minimum(gu[:, :D_FF], SWIGLU_LIMIT)
        up = jnp.clip(gu[:, D_FF:], -SWIGLU_LIMIT, SWIGLU_LIMIT)
        glu = gate * jax.nn.sigmoid(gate * SWIGLU_ALPHA)
        return ((up + 1.0) * glu) @ w_down[e] + b_down[e]

    ys = lax.map(expert_block, (xs, block_e)).reshape(P, D)
    out = jnp.zeros((T + 1, D), jnp.float32).at[slot_tok].add(ys.astype(jnp.float32) * slot_w[:, None])
    return out[:T].astype(h.dtype).reshape(B, S, D)


def setup_inputs(seed: int = 0) -> dict:
    key = jax.random.key(seed)
    ks = jax.random.split(key, 26)
    L = DEPTH
    f32 = jnp.float32

    def w(k, shape, fan_in):
        return jax.random.normal(k, shape, f32) * (fan_in ** -0.5)

    def gain(k, shape):
        return 1.0 + 0.02 * jax.random.normal(k, shape, f32)

    def bias(k, shape):
        return 0.01 * jax.random.normal(k, shape, f32)

    start = jax.random.randint(ks[1], (BATCH, 1), 0, 65536, dtype=jnp.int32)
    return {
        "x": jax.random.normal(ks[0], (BATCH, SEQ, D_MODEL), f32),
        "positions": start + jnp.arange(SEQ, dtype=jnp.int32)[None, :],
        "norm_mix_g": gain(ks[2], (L, D_MODEL)),
        "w_in": w(ks[3], (L, D_MODEL, IN_WIDTH), D_MODEL),
        "q_latent_g": gain(ks[4], (L, Q_LORA_RANK)),
        "w_uq": w(ks[5], (L, Q_LORA_RANK, MLA_HEADS * QK_HEAD_DIM), Q_LORA_RANK),
        "kv_latent_g": gain(ks[6], (L, KV_LORA_RANK)),
        "w_ukv": w(ks[7], (L, KV_LORA_RANK, MLA_HEADS * (QK_NOPE_DIM + V_HEAD_DIM)), KV_LORA_RANK),
        "q_head_g": gain(ks[8], (L, QK_HEAD_DIM)),
        "k_head_g": gain(ks[9], (L, QK_HEAD_DIM)),
        "conv_dw_w": w(ks[10], (L, CONV_KERNEL, CONV_WIDTH), CONV_KERNEL),
        "conv_dw_b": bias(ks[11], (L, CONV_WIDTH)),
        "conv_ln_g": gain(ks[12], (L, CONV_WIDTH)),
        "conv_ln_b": bias(ks[13], (L, CONV_WIDTH)),
        "attn_out_g": gain(ks[14], (L, ATTN_WIDTH)),
        "conv_out_g": gain(ks[15], (L, CONV_WIDTH)),
        "w_out": w(ks[16], (L, D_MODEL, D_MODEL), D_MODEL),
        "norm_ffn_g": gain(ks[17], (L, D_MODEL)),
        "router_w": w(ks[18], (L, D_MODEL, N_EXPERTS), D_MODEL),
        "router_b": bias(ks[19], (L, N_EXPERTS)),
        "w_gate_up": w(ks[20], (L, N_EXPERTS, D_MODEL, 2 * D_FF), D_MODEL),
        "b_gate_up": bias(ks[21], (L, N_EXPERTS, 2 * D_FF)),
        "w_down": w(ks[22], (L, N_EXPERTS, D_FF, D_MODEL), D_FF),
        "b_down": bias(ks[23], (L, N_EXPERTS, D_MODEL)),
    }


def reference(x, positions, norm_mix_g, w_in, q_latent_g, w_uq, kv_latent_g, w_ukv, q_head_g,
              k_head_g, conv_dw_w, conv_dw_b, conv_ln_g, conv_ln_b, attn_out_g, conv_out_g, w_out,
              norm_ffn_g, router_w, router_b, w_gate_up, b_gate_up, w_down, b_down):
    cos, sin = rope_tables(positions)
    o1 = Q_LORA_RANK
    o2 = o1 + KV_LORA_RANK
    o3 = o2 + QK_ROPE_DIM
    for l in range(DEPTH):
        h = rms_norm(x, norm_mix_g[l])
        p = h @ w_in[l]
        attn = mla(p[..., :o1], p[..., o1:o2], p[..., o2:o3], cos, sin,
                   q_latent_g[l], w_uq[l], kv_latent_g[l], w_ukv[l], q_head_g[l], k_head_g[l])
        conv = conformer_conv(p[..., o3:], conv_dw_w[l], conv_dw_b[l], conv_ln_g[l], conv_ln_b[l])
        mixed = jnp.concatenate([rms_norm(attn, attn_out_g[l]), rms_norm(conv, conv_out_g[l])], axis=-1)
        x = x + mixed @ w_out[l]
        h = rms_norm(x, norm_ffn_g[l])
        x = x + moe(h, router_w[l], router_b[l], w_gate_up[l], b_gate_up[l], w_down[l], b_down[l])
    return x
```

```cpp
#include <hip/hip_runtime.h>
#include <cstdio>
#include <cstdint>

#ifndef MK_PER_PHASE
#define MK_PER_PHASE 1
#endif

#define GAS __attribute__((address_space(1)))
#define LAS __attribute__((address_space(3)))
typedef unsigned short bf16;
typedef unsigned v4u __attribute__((ext_vector_type(4)));
typedef unsigned v2u __attribute__((ext_vector_type(2)));
typedef float f32x4 __attribute__((ext_vector_type(4)));
typedef float f32x2 __attribute__((ext_vector_type(2)));
typedef float f32x16 __attribute__((ext_vector_type(16)));
typedef short bf16x8 __attribute__((ext_vector_type(8)));
typedef short s16x4 __attribute__((ext_vector_type(4)));
typedef __bf16 bf16x2_t __attribute__((ext_vector_type(2)));
typedef GAS unsigned gu32;

constexpr int NB = 8, S = 4096, T = NB * S, D = 1024;
constexpr int NH = 8, DQK = 96, DV = 64;
constexpr int QL = 384, KVL = 128, CW = 512, AW = 512, CK = 31, INW = 1568;
constexpr int NE = 32, DFF = 1024;
constexpr float EPS = 1e-6f;
constexpr int NIN1 = 1792;
constexpr int MAXSLOT = T * 4 + NE * 256;
constexpr float C2 = 0.14724445f;
constexpr int NPH = 11;

constexpr size_t MiB = 1u << 20;
constexpr size_t WS_CTL = 0, CTL_ZERO_BYTES = 1 * MiB;
constexpr size_t WS_WIN = 2 * MiB, WS_WUQ = 6 * MiB, WS_WUKV = 7 * MiB, WS_WOUT = 8 * MiB, WS_RT = 10 * MiB, WS_CS = 12 * MiB;
constexpr size_t WS_RSQ = 16 * MiB, WS_RSKV = WS_RSQ + 128 * 1024, WS_KSS = WS_RSKV + 128 * 1024;
constexpr size_t WS_KR = 17 * MiB, WS_POS = 21 * MiB, WS_GW = WS_POS + 512 * 1024, WS_TOKL = 22 * MiB, WS_RSL = 26 * MiB;
constexpr size_t WS_WGU = 32 * MiB, WS_WD = 160 * MiB, WS_H1 = 224 * MiB, WS_CQKV = 288 * MiB, WS_Y = 320 * MiB, WS_KPE = 352 * MiB;
constexpr size_t WS_QRAW = 356 * MiB, WS_KF = 404 * MiB, WS_VF = 452 * MiB, WS_AO = 484 * MiB, WS_MIX = 516 * MiB, WS_X1B = 580 * MiB, WS_ACT = 644 * MiB;
constexpr size_t WS_YS = 224 * MiB;
constexpr size_t WS_END = 916 * MiB;
static_assert(WS_ACT + (size_t)MAXSLOT * 1024 * 2 <= WS_END && WS_YS + (size_t)MAXSLOT * 1024 * 2 <= WS_MIX, "ws map");
constexpr int CW_TMO = 0, CW_BAR = 4096, CW_CNT = 8192;

constexpr int RING_BYTES = 131072;
constexpr int MISC_OFF = RING_BYTES;
constexpr int LCNT_OFF = MISC_OFF + 64;
constexpr int LBASE_OFF = LCNT_OFF + 128;
constexpr int TS_OFF = LBASE_OFF + 128;
constexpr int ECNT_OFF = TS_OFF + 160;
constexpr int LDS_BYTES = 147456;

#define LDS_WAIT() asm volatile("s_waitcnt lgkmcnt(0)" ::: "memory")
#define VM_WAIT() asm volatile("s_waitcnt vmcnt(0)" ::: "memory")

__device__ __forceinline__ unsigned pk2(float lo, float hi) { f32x2 v = {lo, hi}; bf16x2_t b = __builtin_convertvector(v, bf16x2_t); return __builtin_bit_cast(unsigned, b); }
__device__ __forceinline__ float bflo(unsigned w) { return __builtin_bit_cast(float, w << 16); }
__device__ __forceinline__ float bfhi(unsigned w) { return __builtin_bit_cast(float, w & 0xffff0000u); }
__device__ __forceinline__ float wave_sum(float v) {
#pragma unroll
    for (int o = 1; o < 64; o <<= 1) v += __shfl_xor(v, o);
    return v;
}
__device__ __forceinline__ float wave_max(float v) {
#pragma unroll
    for (int o = 1; o < 64; o <<= 1) v = fmaxf(v, __shfl_xor(v, o));
    return v;
}
__device__ __forceinline__ float swap_sum(float v) { auto rr = __builtin_amdgcn_permlane32_swap(__float_as_uint(v), __float_as_uint(v), false, false); return __uint_as_float(rr[0]) + __uint_as_float(rr[1]); }
__device__ __forceinline__ float fast_exp2(float x) { return __builtin_amdgcn_exp2f(x); }
__device__ __forceinline__ float sigmoidf_(float g) { return __builtin_amdgcn_rcpf(1.f + fast_exp2(-1.4426950408889634f * g)); }

#define XB_TMO      128
#define XB_XCNT(j)  (256  + 64 * (j))
#define XB_XSUB(j)  (1280 + 64 * (j))
#define XB_XGEN(j)  (2304 + 64 * (j))
#define XB_TOP      3328
#define XB_TOPGEN   3392
#define XCD_BAR_WORDS 3456
#define XB_SPIN_CAP (1u << 18)
__device__ __forceinline__ unsigned xb_ld(unsigned* p)              { return __hip_atomic_load(p, __ATOMIC_RELAXED, __HIP_MEMORY_SCOPE_AGENT); }
__device__ __forceinline__ unsigned xb_add(unsigned* p, unsigned v) { return __hip_atomic_fetch_add(p, v, __ATOMIC_RELAXED, __HIP_MEMORY_SCOPE_AGENT); }
__device__ __forceinline__ unsigned xb_xcc_id() { return (unsigned)__builtin_amdgcn_s_getreg((3 << 11) | 20) & 0xFu; }
#define XB_SPIN(cond, bar) do { unsigned _sp = 0; while (cond) { __builtin_amdgcn_s_sleep(1); \
    if ((++_sp & 255u) == 0u) { if (xb_ld(&(bar)[XB_TMO])) break; if (_sp > XB_SPIN_CAP) { atomicAdd(&(bar)[XB_TMO], 1u); break; } } } } while (0)
struct XcdBarrier { unsigned* bar; unsigned x; volatile LAS unsigned* st; };
__device__ __forceinline__ XcdBarrier xcd_barrier_post(unsigned* bar, volatile LAS unsigned* st) {
    XcdBarrier b; b.bar = bar; b.x = xb_xcc_id(); b.st = st;
    if (threadIdx.x == 0) (void)xb_add(&bar[XB_XCNT(b.x)], 1u);
    return b;
}
__device__ __forceinline__ void xcd_barrier_complete(unsigned* bar, unsigned x, unsigned& nloc, unsigned& nx) {
    const unsigned G = gridDim.x * gridDim.y * gridDim.z;
    unsigned sum, cnt, mine, sp = 0u;
    for (;;) {
        sum = 0u; cnt = 0u; mine = 0u;
#pragma unroll
        for (unsigned j = 0; j < 16; ++j) { const unsigned c = xb_ld(&bar[XB_XCNT(j)]); sum += c; cnt += (c > 0u) ? 1u : 0u; mine = (j == x) ? c : mine; }
        if (sum == G) break;
        __builtin_amdgcn_s_sleep(1);
        if ((++sp & 255u) == 0u) { if (xb_ld(&bar[XB_TMO])) break; if (sp > XB_SPIN_CAP) { atomicAdd(&bar[XB_TMO], 1u); break; } }
    }
    nloc = mine > 0u ? mine : 1u; nx = cnt > 0u ? cnt : 1u;
}
__device__ __forceinline__ void xcd_barrier(const XcdBarrier& b) {
    asm volatile("s_waitcnt vmcnt(0)" ::: "memory");
    __syncthreads();
    if (threadIdx.x == 0) {
        unsigned* bar = b.bar;
        __builtin_amdgcn_s_waitcnt(0);
        unsigned nloc = b.st[0], nx = b.st[1];
        if (nloc == 0u) { xcd_barrier_complete(bar, b.x, nloc, nx); b.st[0] = nloc; b.st[1] = nx; }
        const unsigned old = xb_add(&bar[XB_XSUB(b.x)], 1u);
        const unsigned gen = old / nloc;
        if (old + 1u == (gen + 1u) * nloc) {
            __builtin_amdgcn_fence(__ATOMIC_RELEASE, "agent");
            asm volatile("s_waitcnt vmcnt(0)" ::: "memory");
            const unsigned og = xb_add(&bar[XB_TOP], 1u);
            const unsigned tg = og / nx;
            if (og + 1u == (tg + 1u) * nx) xb_add(&bar[XB_TOPGEN], 1u);
            else XB_SPIN(xb_ld(&bar[XB_TOPGEN]) == tg, bar);
            __builtin_amdgcn_fence(__ATOMIC_ACQUIRE, "agent");
            xb_add(&bar[XB_XGEN(b.x)], 1u);
            asm volatile("s_waitcnt vmcnt(0)" ::: "memory");
        } else {
            XB_SPIN(xb_ld(&bar[XB_XGEN(b.x)]) == gen, bar);
            __builtin_amdgcn_fence(__ATOMIC_ACQUIRE, "agent");
            asm volatile("s_waitcnt vmcnt(0)" ::: "memory");
        }
    }
    __syncthreads();
}

namespace gm {
constexpr int BM = 256, BK = 64, HALF = 128, HTB = HALF * BK * 2, NXCD = 8, WGM = 8;
__host__ __device__ __forceinline__ int lds_byte(int r, int c) { const int st = (r >> 4) * 2 + (c >> 5), rr = r & 15, cc = c & 31, ob = rr * 64 + cc * 2; return st * 1024 + (ob ^ (((ob >> 9) & 1) << 5)); }
__host__ __device__ __forceinline__ void stage_rc(int b, int& R, int& C) { const int st = b / 1024, sb = b % 1024, swz = sb ^ (((sb >> 9) & 1) << 5); R = (st >> 1) * 16 + swz / 64; C = (st & 1) * 32 + (swz % 64) / 2; }
__host__ __device__ __forceinline__ int perm32(int rho) { const int n = rho >> 4, i = rho & 15; return 8 * (i >> 2) + 4 * n + (i & 3); }

struct Unit { int pm, pn, e, rt; };

struct DenseSched {
    const char* A; const char* Bt; int K, lda;
    int nM, nN, nwg, G, c;
    __device__ __forceinline__ void init(const void* A_, const void* Bt_, int M, int N, int K_, int lda_, int G_, int c_) { A = (const char*)A_; Bt = (const char*)Bt_; K = K_; lda = lda_; nM = M / BM; nN = N / BM; nwg = nM * nN; G = G_; c = c_; }
    __device__ __forceinline__ bool next(int i, Unit& u) const {
        const long L = (long)i * G + c; if (L >= nwg) return false;
        int wgid = (int)L; { const int q = nwg / NXCD, r = nwg % NXCD, xcd = wgid % NXCD, off = wgid / NXCD; wgid = (xcd < r ? xcd * (q + 1) : r * (q + 1) + (xcd - r) * q) + off; }
        const int nig = WGM * nN, gid = wgid / nig, fm = gid * WGM, gsz = (nM - fm) < WGM ? (nM - fm) : WGM;
        u.pm = fm + ((wgid % nig) % gsz); u.pn = (wgid % nig) / gsz; u.e = 0; u.rt = u.pm; return true;
    }
    __device__ __forceinline__ const char* b_tile(const Unit& u) const { return Bt + (size_t)u.pn * BM * K * 2; }
    static constexpr bool GATHER = false;
    __device__ __forceinline__ const char* a_tile(const Unit& u) const { return A + (size_t)u.pm * BM * lda * 2; }
    __device__ __forceinline__ void a_off(const Unit&, const int (&)[2], const int (&)[2], unsigned (&)[2][2]) const {}
};
template <bool GATH> struct MoeSched {
    static constexpr bool GATHER = GATH;
    const char* A; const char* Bt; int K, lda, N;
    int nct;
    const int* tokl;
    const LAS int* TS; const LAS int* EC;
    int grp, rank, cpg, epg;
    __device__ __forceinline__ bool next(int i, Unit& u) const {
        int L = i * cpg + rank;
        for (int q = 0; q < epg; ++q) {
            const int e = grp * epg + q; const int nt_e = __builtin_amdgcn_readfirstlane(TS[e + 1] - TS[e]); const int nu = nt_e * nct;
            if (L < nu) { u.e = e; u.rt = L / nct; u.pn = L % nct; u.pm = __builtin_amdgcn_readfirstlane(TS[e]) + u.rt; return true; }
            L -= nu;
        }
        return false;
    }
    __device__ __forceinline__ const char* b_tile(const Unit& u) const { return Bt + ((size_t)u.e * N + (size_t)u.pn * BM) * K * 2; }
    __device__ __forceinline__ const char* a_tile(const Unit& u) const { return A + (size_t)u.pm * BM * lda * 2; }
    __device__ __forceinline__ void a_off(const Unit& u, const int (&R)[2], const int (&C)[2], unsigned (&off)[2][2]) const {
        const int cnt = EC[u.e];
#pragma unroll
        for (int h = 0; h < 2; ++h)
#pragma unroll
            for (int i = 0; i < 2; ++i) { const int sl = u.rt * BM + h * HALF + R[i]; const int tok = (sl < cnt) ? tokl[(size_t)u.e * T + sl] : 0; off[h][i] = (unsigned)(((size_t)tok * lda + C[i]) * 2); }
    }
};

template <class Epi, class Sched>
__device__ __forceinline__ void gemm_phase(LAS unsigned char* lds, const Sched& S, const Epi& E) {
    const int tid = threadIdx.x, wid = __builtin_amdgcn_readfirstlane(tid >> 6), lane = tid & 63, wr = wid >> 2, wc = wid & 3, fr = lane & 15, fq = lane >> 4;
    const int K = S.K, nt = K / BK;
    int R[2], C[2]; unsigned voffB[2];
#pragma unroll
    for (int i = 0; i < 2; ++i) { stage_rc(tid * 16 + i * 8192, R[i], C[i]); const int Rb = (R[i] & ~31) + perm32(R[i] & 31); voffB[i] = (unsigned)(Rb * K + C[i]) * 2u; }
    const size_t kstep = (size_t)(BK * 2);
    const size_t hstepB = (size_t)HALF * K * 2;
    const unsigned ldsw = (unsigned)wid * 1024u;
    const int aoff = lds_byte(wr * 64 + fr, fq * 8), boff = lds_byte(wc * 32 + fr, fq * 8);
#define G_SA(b, h) (((b) * 2 + (h)) * HTB)
#define G_SB(b, h) ((4 + (b) * 2 + (h)) * HTB)
#define G_STAGE(bufoff, gbase, o0, o1) do { \
        __builtin_amdgcn_global_load_lds((const unsigned*)((const char*)(gbase) + (o0)), (LAS unsigned*)(lds + (bufoff) + ldsw), 16, 0, 0); \
        __builtin_amdgcn_global_load_lds((const unsigned*)((const char*)(gbase) + (o1)), (LAS unsigned*)(lds + (bufoff) + ldsw + 8192), 16, 0, 0); } while (0)
#define G_LDA(dst, b, h) do { _Pragma("unroll") for (int m = 0; m < 4; ++m) _Pragma("unroll") for (int k = 0; k < 2; ++k) dst[m][k] = *(const LAS bf16x8*)(lds + G_SA(b, h) + aoff + m * 2048 + k * 1024); } while (0)
#define G_LDB(dst, b, h) do { _Pragma("unroll") for (int n = 0; n < 2; ++n) _Pragma("unroll") for (int k = 0; k < 2; ++k) dst[n][k] = *(const LAS bf16x8*)(lds + G_SB(b, h) + boff + n * 2048 + k * 1024); } while (0)
#define G_MMA(ai, bj, At, Bt) do { __builtin_amdgcn_s_setprio(1); _Pragma("unroll") for (int m = 0; m < 4; ++m) _Pragma("unroll") for (int n = 0; n < 2; ++n) _Pragma("unroll") for (int k = 0; k < 2; ++k) \
        acc[ai][bj][m][n] = __builtin_amdgcn_mfma_f32_16x16x32_bf16(Bt[n][k], At[m][k], acc[ai][bj][m][n], 0, 0, 0); __builtin_amdgcn_s_setprio(0); } while (0)
#define G_WAIT_V(n) asm volatile("s_waitcnt vmcnt(" #n ")" ::: "memory")
#define G_WAIT_L(n) asm volatile("s_waitcnt lgkmcnt(" #n ")" ::: "memory")
#define G_BAR __builtin_amdgcn_s_barrier()
#define G_SCHED __builtin_amdgcn_sched_barrier(0)
    Unit cur, nxt; int ui = 0;
    if (!S.next(0, cur)) return;
    f32x4 acc[2][2][4][2];
#pragma unroll
    for (int a = 0; a < 2; ++a)
#pragma unroll
        for (int b = 0; b < 2; ++b)
#pragma unroll
            for (int m = 0; m < 4; ++m)
#pragma unroll
                for (int n = 0; n < 2; ++n) acc[a][b][m][n] = (f32x4){0.f, 0.f, 0.f, 0.f};
    bf16x8 At[4][2], B0[2][2], B1[2][2];
    unsigned off[2][2], noff[2][2]; unsigned voffA[2];
    const size_t hstepA = (size_t)HALF * S.lda * 2;
    const char* cA = S.A; const char* nA = S.A;
    if constexpr (Sched::GATHER) { S.a_off(cur, R, C, off); voffA[0] = voffA[1] = 0u; }
    else { cA = S.a_tile(cur); voffA[0] = (unsigned)(R[0] * S.lda + C[0]) * 2u; voffA[1] = (unsigned)(R[1] * S.lda + C[1]) * 2u; off[0][0] = off[0][1] = off[1][0] = off[1][1] = 0u; noff[0][0] = noff[0][1] = noff[1][0] = noff[1][1] = 0u; }
#define G_STAGE_A(bufoff, h, ktb, NX) do { \
        if constexpr (Sched::GATHER) { G_STAGE(bufoff, cA + (ktb), (NX) ? noff[h][0] : off[h][0], (NX) ? noff[h][1] : off[h][1]); } \
        else { G_STAGE(bufoff, ((NX) ? nA : cA) + (h) * hstepA + (ktb), voffA[0], voffA[1]); } } while (0)
    const char* cB = S.b_tile(cur);
    G_STAGE(G_SB(0, 0), cB, voffB[0], voffB[1]); G_STAGE(G_SB(0, 1), cB + hstepB, voffB[0], voffB[1]); G_STAGE_A(G_SA(0, 0), 0, 0, false); G_STAGE_A(G_SA(0, 1), 1, 0, false);
    if (wr == 1) G_BAR;
    G_WAIT_V(2); G_BAR;
    G_STAGE(G_SB(1, 0), cB + kstep, voffB[0], voffB[1]); G_STAGE_A(G_SA(1, 0), 0, kstep, false); G_STAGE(G_SB(1, 1), cB + hstepB + kstep, voffB[0], voffB[1]);
    G_WAIT_V(6); G_BAR;
    for (;;) {
        const bool has_next = S.next(ui + 1, nxt);
        if constexpr (Sched::GATHER) { if (has_next) S.a_off(nxt, R, C, noff); else { noff[0][0] = off[0][0]; noff[0][1] = off[0][1]; noff[1][0] = off[1][0]; noff[1][1] = off[1][1]; } }
        else nA = has_next ? S.a_tile(nxt) : cA;
        const char* nB = has_next ? S.b_tile(nxt) : cB;
        for (int t = 0; t < nt; t += 2) {
            const bool last = (t == nt - 2);
            const size_t k1 = (size_t)(t + 1) * kstep;
            const size_t k2 = last ? 0 : (size_t)(t + 2) * kstep, k3 = k2 + kstep;
            const char* b2 = last ? nB : cB + (size_t)(t + 2) * kstep; const char* b3 = b2 + kstep;
            G_LDB(B0, 0, 0); G_LDB(B1, 0, 1); G_SCHED; G_LDA(At, 0, 0); G_STAGE_A(G_SA(1, 1), 1, k1, false);
            G_WAIT_V(8); G_WAIT_L(0); G_BAR; G_MMA(0, 0, At, B0); G_MMA(0, 1, At, B1); G_BAR; G_SCHED;
            G_LDA(At, 0, 1); G_STAGE(G_SB(0, 0), b2, voffB[0], voffB[1]); G_STAGE(G_SB(0, 1), b2 + hstepB, voffB[0], voffB[1]); G_STAGE_A(G_SA(0, 0), 0, k2, last);
            G_WAIT_V(8); G_WAIT_L(0); G_BAR; G_MMA(1, 0, At, B0); G_MMA(1, 1, At, B1); G_BAR; G_SCHED;
            G_LDB(B0, 1, 0); G_LDB(B1, 1, 1); G_SCHED; G_LDA(At, 1, 0); G_STAGE_A(G_SA(0, 1), 1, k2, last);
            G_WAIT_V(8); G_WAIT_L(0); G_BAR; G_MMA(0, 0, At, B0); G_MMA(0, 1, At, B1); G_BAR; G_SCHED;
            G_LDA(At, 1, 1); G_STAGE(G_SB(1, 0), b3, voffB[0], voffB[1]); G_STAGE(G_SB(1, 1), b3 + hstepB, voffB[0], voffB[1]); G_STAGE_A(G_SA(1, 0), 0, k3, last);
            G_WAIT_V(8); G_WAIT_L(0); G_BAR; G_MMA(1, 0, At, B0); G_MMA(1, 1, At, B1); G_BAR; G_SCHED;
        }
        if (wr == 0) G_BAR;
        { int fr_e = fr, fq_e = fq; asm volatile("" : "+v"(fr_e), "+v"(fq_e));
          E(acc, cur, wr, wc, fr_e, fq_e); }
        if (!has_next) break;
#pragma unroll
        for (int a = 0; a < 2; ++a)
#pragma unroll
            for (int b = 0; b < 2; ++b)
#pragma unroll
                for (int m = 0; m < 4; ++m)
#pragma unroll
                    for (int n = 0; n < 2; ++n) acc[a][b][m][n] = (f32x4){0.f, 0.f, 0.f, 0.f};
        cur = nxt; cB = nB; ++ui;
        if constexpr (Sched::GATHER) { off[0][0] = noff[0][0]; off[0][1] = noff[0][1]; off[1][0] = noff[1][0]; off[1][1] = noff[1][1]; } else cA = nA;
        if (wr == 1) G_BAR;
    }
    G_WAIT_V(0);
    G_BAR;
#undef G_SA
#undef G_SB
#undef G_STAGE
#undef G_STAGE_A
#undef G_LDA
#undef G_LDB
#undef G_MMA
#undef G_WAIT_V
#undef G_WAIT_L
#undef G_BAR
#undef G_SCHED
}

typedef f32x4 Acc[2][2][4][2];
__device__ __forceinline__ v4u pack8(const f32x4 a, const f32x4 b) { v4u w; w.x = pk2(a[0], a[1]); w.y = pk2(a[2], a[3]); w.z = pk2(b[0], b[1]); w.w = pk2(b[2], b[3]); return w; }

struct EpiPlain {
    bf16* O; int ldc;
    __device__ __forceinline__ void operator()(const Acc& acc, const Unit& u, int wr, int wc, int fr, int fq) const {
        const int row0 = u.pm * BM + wr * 64 + fr, col0 = u.pn * BM + wc * 32 + 8 * fq;
#pragma unroll
        for (int ai = 0; ai < 2; ++ai)
#pragma unroll
            for (int m = 0; m < 4; ++m) { bf16* rowp = O + (size_t)(row0 + ai * HALF + m * 16) * ldc + col0;
#pragma unroll
                for (int bj = 0; bj < 2; ++bj) *(v4u*)(rowp + bj * HALF) = pack8(acc[ai][bj][m][0], acc[ai][bj][m][1]); }
    }
};
struct EpiIn {
    bf16* CQKV; bf16* Y; float* KPE;
    __device__ __forceinline__ void operator()(const Acc& acc, const Unit& u, int wr, int wc, int fr, int fq) const {
        const int row0 = u.pm * BM + wr * 64 + fr;
        if (u.pn < 2) {
#pragma unroll
            for (int ai = 0; ai < 2; ++ai)
#pragma unroll
                for (int m = 0; m < 4; ++m) { bf16* rowp = CQKV + (size_t)(row0 + ai * HALF + m * 16) * 512 + u.pn * BM + wc * 32 + 8 * fq;
#pragma unroll
                    for (int bj = 0; bj < 2; ++bj) *(v4u*)(rowp + bj * HALF) = pack8(acc[ai][bj][m][0], acc[ai][bj][m][1]); }
        } else if (u.pn < 6) {
            const int cb = (u.pn - 2) * 128 + wc * 32 + 8 * fq;
#pragma unroll
            for (int ai = 0; ai < 2; ++ai)
#pragma unroll
                for (int m = 0; m < 4; ++m) {
                    f32x4 y0, y1;
#pragma unroll
                    for (int i = 0; i < 4; ++i) { y0[i] = acc[ai][0][m][0][i] * sigmoidf_(acc[ai][1][m][0][i]); y1[i] = acc[ai][0][m][1][i] * sigmoidf_(acc[ai][1][m][1][i]); }
                    *(v4u*)(Y + (size_t)(row0 + ai * HALF + m * 16) * 512 + cb) = pack8(y0, y1); }
        } else {
            if (wc == 0) {
#pragma unroll
                for (int ai = 0; ai < 2; ++ai)
#pragma unroll
                    for (int m = 0; m < 4; ++m) { float* p = KPE + (size_t)(row0 + ai * HALF + m * 16) * 32 + 8 * fq; *(f32x4*)p = acc[ai][0][m][0]; *(f32x4*)(p + 4) = acc[ai][0][m][1]; }
            }
        }
    }
};
struct EpiKV {
    bf16* KF; bf16* VF; const float* rskv; const float* kss; const float* kr; const float* gk;
    __device__ __forceinline__ void operator()(const Acc& acc, const Unit& u, int wr, int wc, int fr, int fq) const {
        const int row0 = u.pm * BM + wr * 64 + fr; const int head = 2 * u.pn + (wc & 1);
        if (wc < 2) {
#pragma unroll
            for (int ai = 0; ai < 2; ++ai)
#pragma unroll
                for (int m = 0; m < 4; ++m) { const int row = row0 + ai * HALF + m * 16; const float rs = rskv[row];
                    float ss = 0.f;
#pragma unroll
                    for (int bj = 0; bj < 2; ++bj)
#pragma unroll
                        for (int n = 0; n < 2; ++n) { const f32x4 q = acc[ai][bj][m][n]; ss += (q[0] * q[0] + q[1] * q[1]) + (q[2] * q[2] + q[3] * q[3]); }
                    ss += __shfl_xor(ss, 16); ss += __shfl_xor(ss, 32);
                    const float rn = __builtin_amdgcn_rsqf((ss * rs * rs + kss[row]) * (1.f / 96.f) + EPS); const float sc = rs * rn;
                    bf16* kp = KF + (size_t)row * 768 + head * 96;
#pragma unroll
                    for (int bj = 0; bj < 2; ++bj) { const f32x4 g0 = *(const f32x4*)(gk + 32 * bj + 8 * fq), g1 = *(const f32x4*)(gk + 32 * bj + 8 * fq + 4);
                        *(v4u*)(kp + 32 * bj + 8 * fq) = pack8(acc[ai][bj][m][0] * g0 * sc, acc[ai][bj][m][1] * g1 * sc); }
                    const f32x4 r0 = *(const f32x4*)(kr + (size_t)row * 32 + 8 * fq), r1 = *(const f32x4*)(kr + (size_t)row * 32 + 8 * fq + 4);
                    *(v4u*)(kp + 64 + 8 * fq) = pack8(r0 * rn, r1 * rn); asm volatile("" ::: "memory"); }
        } else {
#pragma unroll
            for (int ai = 0; ai < 2; ++ai)
#pragma unroll
                for (int m = 0; m < 4; ++m) { const int row = row0 + ai * HALF + m * 16; const float rs = rskv[row]; bf16* vp = VF + (size_t)row * 512 + head * 64 + 8 * fq;
#pragma unroll
                    for (int bj = 0; bj < 2; ++bj) *(v4u*)(vp + 32 * bj) = pack8(acc[ai][bj][m][0] * rs, acc[ai][bj][m][1] * rs); asm volatile("" ::: "memory"); }
        }
    }
};
struct EpiX1 {
    const float* X; float* OUT; bf16* X1B;
    __device__ __forceinline__ void operator()(const Acc& acc, const Unit& u, int wr, int wc, int fr, int fq) const {
        const int row0 = u.pm * BM + wr * 64 + fr, col0 = u.pn * BM + wc * 32 + 8 * fq;
#pragma unroll
        for (int ai = 0; ai < 2; ++ai)
#pragma unroll
            for (int m = 0; m < 4; ++m) { const size_t o = (size_t)(row0 + ai * HALF + m * 16) * D + col0;
#pragma unroll
                for (int bj = 0; bj < 2; ++bj) { const f32x4 a = acc[ai][bj][m][0] + *(const f32x4*)(X + o + bj * HALF), b = acc[ai][bj][m][1] + *(const f32x4*)(X + o + bj * HALF + 4);
                    *(f32x4*)(OUT + o + bj * HALF) = a; *(f32x4*)(OUT + o + bj * HALF + 4) = b; *(v4u*)(X1B + o + bj * HALF) = pack8(a, b); } asm volatile("" ::: "memory"); }
    }
};
struct EpiGU {
    bf16* ACT; const float* bgu; const float* rsl; const LAS int* EC;
    __device__ __forceinline__ void operator()(const Acc& acc, const Unit& u, int wr, int wc, int fr, int fq) const {
        const int r0 = wr * 64 + fr; const int cb = u.pn * 128 + wc * 32 + 8 * fq; const int cnt = EC[u.e];
        const float* bg = bgu + (size_t)u.e * 2048 + cb;
        const f32x4 bg0 = *(const f32x4*)bg, bg1 = *(const f32x4*)(bg + 4), bu0 = *(const f32x4*)(bg + 1024), bu1 = *(const f32x4*)(bg + 1028);
#pragma unroll
        for (int ai = 0; ai < 2; ++ai)
#pragma unroll
            for (int m = 0; m < 4; ++m) { const int rr = r0 + ai * HALF + m * 16; const int sl = u.rt * BM + rr;
                const float rs = (sl < cnt) ? rsl[(size_t)u.e * T + sl] : 0.f;
                f32x4 o[2];
#pragma unroll
                for (int n = 0; n < 2; ++n) { const f32x4 gb = n ? bg1 : bg0, ub = n ? bu1 : bu0;
#pragma unroll
                    for (int i = 0; i < 4; ++i) { float gt = fminf(acc[ai][0][m][n][i] * rs + gb[i], 7.f); float up = fminf(fmaxf(acc[ai][1][m][n][i] * rs + ub[i], -7.f), 7.f);
                        o[n][i] = (up + 1.f) * gt * sigmoidf_(1.702f * gt); } }
                *(v4u*)(ACT + (size_t)(u.pm * BM + rr) * 1024 + cb) = pack8(o[0], o[1]); asm volatile("" ::: "memory"); }
    }
};
struct EpiDown {
    bf16* YS; const float* bd;
    __device__ __forceinline__ void operator()(const Acc& acc, const Unit& u, int wr, int wc, int fr, int fq) const {
        const int row0 = u.pm * BM + wr * 64 + fr, col0 = u.pn * BM + wc * 32 + 8 * fq;
        f32x4 b[2][2];
#pragma unroll
        for (int bj = 0; bj < 2; ++bj) { b[bj][0] = *(const f32x4*)(bd + (size_t)u.e * 1024 + col0 + bj * HALF); b[bj][1] = *(const f32x4*)(bd + (size_t)u.e * 1024 + col0 + bj * HALF + 4); }
#pragma unroll
        for (int ai = 0; ai < 2; ++ai)
#pragma unroll
            for (int m = 0; m < 4; ++m) { bf16* rowp = YS + (size_t)(row0 + ai * HALF + m * 16) * 1024 + col0;
#pragma unroll
                for (int bj = 0; bj < 2; ++bj) *(v4u*)(rowp + bj * HALF) = pack8(acc[ai][bj][m][0] + b[bj][0], acc[ai][bj][m][1] + b[bj][1]); }
    }
};
}

struct Args {
    const float* x; const int* positions; const float* norm_mix_g; const float* w_in; const float* q_latent_g; const float* w_uq; const float* kv_latent_g; const float* w_ukv;
    const float* q_head_g; const float* k_head_g; const float* conv_dw_w; const float* conv_dw_b; const float* conv_ln_g; const float* conv_ln_b; const float* attn_out_g; const float* conv_out_g;
    const float* w_out; const float* norm_ffn_g; const float* router_w; const float* router_b; const float* w_gate_up; const float* b_gate_up; const float* w_down; const float* b_down;
    float* out; unsigned char* ws; int ph_lo, ph_hi;
};

__device__ __forceinline__ void tr_item(const float* __restrict__ W, int ldw, int n0s, const float* __restrict__ gain, bf16* WT, int K, int n0d, int k0, LAS float* scr, int lane) {
    const int c = lane & 7;
    if (n0s < 0) {
#pragma unroll
        for (int j = 0; j < 4; ++j) { const int n = (lane >> 3) + 8 * j; *(GAS v4u*)(WT + (size_t)(n0d + n) * K + k0 + 8 * c) = (v4u){0u, 0u, 0u, 0u}; }
        return;
    }
    float v[32];
#pragma unroll
    for (int i = 0; i < 32; ++i) { const int kk = 2 * i + (lane >> 5); v[i] = W[(size_t)(k0 + kk) * ldw + n0s + (lane & 31)]; }
    if (gain) {
#pragma unroll
        for (int i = 0; i < 32; ++i) v[i] *= gain[k0 + 2 * i + (lane >> 5)];
    }
#pragma unroll
    for (int i = 0; i < 32; ++i) { const int kk = 2 * i + (lane >> 5); scr[kk * 33 + (lane & 31)] = v[i]; }
    LDS_WAIT(); asm volatile("" ::: "memory");
#pragma unroll
    for (int j = 0; j < 4; ++j) { const int n = (lane >> 3) + 8 * j; const LAS float* s = scr + (8 * c) * 33 + n;
        v4u o; o.x = pk2(s[0 * 33], s[1 * 33]); o.y = pk2(s[2 * 33], s[3 * 33]); o.z = pk2(s[4 * 33], s[5 * 33]); o.w = pk2(s[6 * 33], s[7 * 33]);
        *(GAS v4u*)(WT + (size_t)(n0d + n) * K + k0 + 8 * c) = o; }
    LDS_WAIT(); asm volatile("" ::: "memory");
}

__device__ __forceinline__ void p0_prologue(const Args& a, LAS unsigned char* lds, int vcu, int G, int wave, int lane, int tid) {
    unsigned char* ws = a.ws;
    LAS float* scr = (LAS float*)(lds + wave * 16384);
    const int gw = vcu * 8 + wave, NGW = G * 8;
    constexpr int I_IN = 16 * 56, I_UQ = 6 * 24, I_UKV = 2 * 32, I_OUT = 16 * 32, I_GU = 32 * 1024, I_D = 32 * 512;
    constexpr int NITEMS = I_IN + I_UQ + I_UKV + I_OUT + I_GU + I_D;
    for (int it = gw; it < NITEMS; it += NGW) {
        int r = it;
        if (r < I_GU) {
            const int e = r >> 10, r2 = r & 1023, nb = r2 & 63, kb = r2 >> 6, tn = nb >> 3, w = nb & 7;
            const int src = (w < 4) ? (128 * tn + 32 * w) : (1024 + 128 * tn + 32 * (w - 4));
            tr_item(a.w_gate_up + (size_t)e * 1024 * 2048, 2048, src, a.norm_ffn_g, (bf16*)(ws + WS_WGU) + (size_t)e * 2048 * 1024, 1024, 32 * nb, 64 * kb, scr, lane); continue; }
        r -= I_GU;
        if (r < I_D) { const int e = r >> 9, r2 = r & 511, nb = r2 & 31, kb = r2 >> 5;
            tr_item(a.w_down + (size_t)e * 1024 * 1024, 1024, 32 * nb, nullptr, (bf16*)(ws + WS_WD) + (size_t)e * 1024 * 1024, 1024, 32 * nb, 64 * kb, scr, lane); continue; }
        r -= I_D;
        if (r < I_IN) { const int nb = r % 56, kb = r / 56; int src;
            if (nb < 16) src = 32 * nb; else if (nb < 48) { const int tn = (nb - 16) >> 3, w = (nb - 16) & 7; src = (w < 4) ? (544 + 128 * tn + 32 * w) : (544 + 512 + 128 * tn + 32 * (w - 4)); } else if (nb == 48) src = 512; else src = -1;
            tr_item(a.w_in, INW, src, nullptr, (bf16*)(ws + WS_WIN), 1024, 32 * nb, 64 * kb, scr, lane); continue; }
        r -= I_IN;
        if (r < I_UQ) { const int nb = r % 24, kb = r / 24; tr_item(a.w_uq, 768, 32 * nb, a.q_latent_g, (bf16*)(ws + WS_WUQ), QL, 32 * nb, 64 * kb, scr, lane); continue; }
        r -= I_UQ;
        if (r < I_UKV) { const int nb = r % 32, kb = r / 32, tn = nb >> 3, w = nb & 7, bj = w >> 2, wc = w & 3; const int head = 2 * tn + (wc & 1), isv = wc >> 1;
            tr_item(a.w_ukv, 1024, head * 128 + isv * 64 + 32 * bj, a.kv_latent_g, (bf16*)(ws + WS_WUKV), KVL, 32 * nb, 64 * kb, scr, lane); continue; }
        r -= I_UKV;
        { const int nb = r % 32, kb = r / 32; tr_item(a.w_out, 1024, 32 * nb, nullptr, (bf16*)(ws + WS_WOUT), 1024, 32 * nb, 64 * kb, scr, lane); }
    }
    {
        f32x4 g[4];
#pragma unroll
        for (int j = 0; j < 4; ++j) g[j] = ((const f32x4*)a.norm_mix_g)[lane + 64 * j];
        bf16* H1 = (bf16*)(ws + WS_H1);
        for (int m = gw; m < T; m += NGW) {
            const GAS f32x4* xr = (const GAS f32x4*)(a.x + (size_t)m * D) + lane;
            f32x4 v[4]; float s = 0.f;
#pragma unroll
            for (int j = 0; j < 4; ++j) { v[j] = xr[64 * j]; s += (v[j].x * v[j].x + v[j].y * v[j].y) + (v[j].z * v[j].z + v[j].w * v[j].w); }
            const float rstd = __builtin_amdgcn_rsqf(wave_sum(s) * (1.f / D) + EPS);
            GAS v2u* o8 = (GAS v2u*)(H1 + (size_t)m * D) + lane;
#pragma unroll
            for (int j = 0; j < 4; ++j) { v2u w; w.x = pk2(v[j].x * rstd * g[j].x, v[j].y * rstd * g[j].y); w.y = pk2(v[j].z * rstd * g[j].z, v[j].w * rstd * g[j].w); o8[64 * j] = w; }
        }
    }
    {
        const int gt = vcu * 512 + tid, NT_ = G * 512;
        f32x2* cs = (f32x2*)(ws + WS_CS);
        for (int idx = gt; idx < T * 16; idx += NT_) {
            const int t = idx >> 4, i = idx & 15;
            const float p4[4] = {1.0f, 1.7782794100389228f, 3.1622776601683795f, 5.623413251903491f};
            float pw = p4[i & 3]; const int dec = i >> 2; pw *= (dec == 0 ? 1.f : dec == 1 ? 10.f : dec == 2 ? 100.f : 1000.f);
            const float inv = 1.0f / pw;
            const float ang = (float)a.positions[t] * inv;
            const double rev = (double)ang * 0.15915494309189535; const double fr = rev - __builtin_rint(rev);
            float sn, cn; sincospif((float)(2.0 * fr), &sn, &cn);
            cs[idx] = (f32x2){cn, sn};
        }
        bf16* RT = (bf16*)(ws + WS_RT);
        for (int idx = gt; idx < 1024 * 32; idx += NT_) {
            const int k = idx >> 5, e = idx & 31; const float v = a.norm_ffn_g[k] * a.router_w[idx];
            const unsigned hi = pk2(v, 0.f) & 0xffffu; const float lo = v - bflo(hi);
            const int s = k >> 5, kq = (k >> 3) & 3, j = k & 7; const int di = ((s * 4 + kq) * 32 + e) * 8 + j;
            RT[di] = (bf16)hi; RT[32768 + di] = (bf16)(pk2(lo, 0.f) & 0xffffu);
        }
    }
}

__device__ __forceinline__ void p2_thin(const Args& a, LAS unsigned char* lds, int vcu, int G, int wave, int lane, int tid) {
    unsigned char* ws = a.ws;
    LAS float* wl = (LAS float*)lds;
    for (int i = tid; i < 32 * 512 / 4; i += 512) ((LAS f32x4*)wl)[i] = (i < CK * 512 / 4) ? ((const f32x4*)a.conv_dw_w)[i] : (f32x4){0.f, 0.f, 0.f, 0.f};
    __syncthreads();
    const bf16* CQKV = (const bf16*)(ws + WS_CQKV); const bf16* Y = (const bf16*)(ws + WS_Y); const float* KPE = (const float*)(ws + WS_KPE);
    float* RSQ = (float*)(ws + WS_RSQ); float* RSKV = (float*)(ws + WS_RSKV); float* KSS = (float*)(ws + WS_KSS); float* KR = (float*)(ws + WS_KR);
    const f32x2* CS = (const f32x2*)(ws + WS_CS); bf16* MIX = (bf16*)(ws + WS_MIX);
    const int c0 = 8 * lane;
    float dwb[8], lng[8], lnb[8], cog[8];
#pragma unroll
    for (int i = 0; i < 8; ++i) { dwb[i] = a.conv_dw_b[c0 + i]; lng[i] = a.conv_ln_g[c0 + i]; lnb[i] = a.conv_ln_b[c0 + i]; cog[i] = a.conv_out_g[c0 + i]; }
    const float gk1 = a.k_head_g[64 + (lane & 15)], gk2 = a.k_head_g[80 + (lane & 15)];
    const int gw = vcu * 8 + wave, NGW = G * 8;
    for (int blk = gw; blk < T / 4; blk += NGW) {
        const int t0 = blk * 4, tb = t0 & (S - 1);
#pragma unroll
        for (int r = 0; r < 4; ++r) { const int row = t0 + r;
            const v4u w = *(const v4u*)(CQKV + (size_t)row * 512 + c0);
            float ss = 0.f;
#pragma unroll
            for (int i = 0; i < 4; ++i) { const float lo = bflo(w[i]), hi = bfhi(w[i]); ss += lo * lo + hi * hi; }
            const float sq = wave_sum(lane < 48 ? ss : 0.f), skv = wave_sum(lane >= 48 ? ss : 0.f);
            const float kv = (lane < 32) ? KPE[(size_t)row * 32 + lane] : 0.f;
            const float ks = wave_sum(kv * kv);
            const float x1 = gk1 * __shfl(kv, lane & 15), x2 = gk2 * __shfl(kv, 16 + (lane & 15));
            const f32x2 cs = CS[(size_t)row * 16 + (lane & 15)];
            if (lane < 16) KR[(size_t)row * 32 + lane] = x1 * cs.x - x2 * cs.y;
            else if (lane < 32) KR[(size_t)row * 32 + lane] = x2 * cs.x + x1 * cs.y;
            if (lane == 0) { RSQ[row] = __builtin_amdgcn_rsqf(sq * (1.f / QL) + EPS); RSKV[row] = __builtin_amdgcn_rsqf(skv * (1.f / KVL) + EPS); KSS[row] = ks; }
        }
        float acc[4][8];
#pragma unroll
        for (int r = 0; r < 4; ++r)
#pragma unroll
            for (int i = 0; i < 8; ++i) acc[r][i] = dwb[i];
        float win[4][8];
#define LOADROW(dst, q) do { v4u w_ = (v4u){0u, 0u, 0u, 0u}; if (tb + (q) >= 0) w_ = *(const v4u*)(Y + (size_t)(t0 + (q)) * 512 + c0); \
            _Pragma("unroll") for (int i_ = 0; i_ < 4; ++i_) { dst[2 * i_] = bflo(w_[i_]); dst[2 * i_ + 1] = bfhi(w_[i_]); } } while (0)
        LOADROW(win[0], -30); LOADROW(win[1], -29); LOADROW(win[2], -28);
#pragma unroll 1
        for (int jb = 0; jb < 32; jb += 4) {
#pragma unroll
            for (int jj = 0; jj < 4; ++jj) { const int j = jb + jj;
                if (j - 27 < 4) LOADROW(win[(jj + 3) & 3], j - 27);
                const f32x4 w0 = *(const LAS f32x4*)(wl + j * 512 + c0), w1 = *(const LAS f32x4*)(wl + j * 512 + c0 + 4);
#pragma unroll
                for (int r = 0; r < 4; ++r)
#pragma unroll
                    for (int i = 0; i < 8; ++i) acc[r][i] += (i < 4 ? w0[i] : w1[i - 4]) * win[(jj + r) & 3][i];
            }
            asm volatile("" ::: "memory");
        }
#undef LOADROW
#pragma unroll
        for (int r = 0; r < 4; ++r) {
            float s1 = 0.f;
#pragma unroll
            for (int i = 0; i < 8; ++i) s1 += acc[r][i];
            const float mean = wave_sum(s1) * (1.f / CW);
            float s2 = 0.f;
#pragma unroll
            for (int i = 0; i < 8; ++i) { acc[r][i] -= mean; s2 += acc[r][i] * acc[r][i]; }
            const float rstd = __builtin_amdgcn_rsqf(wave_sum(s2) * (1.f / CW) + EPS);
            float s3 = 0.f;
#pragma unroll
            for (int i = 0; i < 8; ++i) { const float z = acc[r][i] * rstd * lng[i] + lnb[i]; const float sg = z * sigmoidf_(z); acc[r][i] = sg; s3 += sg * sg; }
            const float r3 = __builtin_amdgcn_rsqf(wave_sum(s3) * (1.f / CW) + EPS);
            v4u o;
#pragma unroll
            for (int i = 0; i < 4; ++i) o[i] = pk2(acc[r][2 * i] * r3 * cog[2 * i], acc[r][2 * i + 1] * r3 * cog[2 * i + 1]);
            *(v4u*)(MIX + (size_t)(t0 + r) * 1024 + 512 + c0) = o;
        }
    }
}

namespace at {
constexpr int KSLOT = 12288, VSLOT = 8192, NSLOT = 3;
constexpr int L_K = 0, L_V = NSLOT * KSLOT, L_WS = L_V + NSLOT * VSLOT, L_OST = L_WS + 8 * 64 * 4, L_END = L_OST + 8 * 4096;
static_assert(L_END <= RING_BYTES, "attention LDS");
__device__ __forceinline__ int crow(int r, int hi) { return (r & 3) + 8 * (r >> 2) + 4 * hi; }
__device__ __forceinline__ void glds16(const void* gsrc, unsigned lds_dst) { unsigned keep;
    asm volatile("s_mov_b32 %0, m0\n\ts_mov_b32 m0, %2\n\ts_nop 0\n\tglobal_load_lds_dwordx4 %1, off\n\ts_mov_b32 m0, %0" : "=&s"(keep) : "v"(gsrc), "s"(lds_dst) : "memory"); }
typedef short v4i16_t __attribute__((ext_vector_type(4)));
__device__ __forceinline__ s16x4 vtr(const LAS char* p) { return __builtin_bit_cast(s16x4, __builtin_amdgcn_ds_read_tr16_b64_v4i16((LAS v4i16_t*)p)); }

__device__ __forceinline__ void attn_unit(const Args& a, int b, int h, int qb, LAS unsigned char* shm3) {
    unsigned char* ws = a.ws;
    const bf16* QRAW = (const bf16*)(ws + WS_QRAW); const bf16* KF = (const bf16*)(ws + WS_KF); const bf16* VF = (const bf16*)(ws + WS_VF); bf16* AO = (bf16*)(ws + WS_AO);
    const float* RSQ = (const float*)(ws + WS_RSQ); const f32x2* CS = (const f32x2*)(ws + WS_CS);
    const int tid = threadIdx.x, lane = tid & 63, r32 = lane & 31, hi = lane >> 5; const int wid = __builtin_amdgcn_readfirstlane(tid >> 6);
    const long rowbase = (long)b * S; const int q0 = qb * 256;
    const int NT = 4 * qb + 4, my_nt = 4 * qb + (wid >> 1) + 1;
    const long myrow = rowbase + q0 + wid * 32 + r32;
    const unsigned lds0 = (unsigned)(uintptr_t)shm3;
    bf16x8 qr[6]; f32x16 negm;
    {
        const bf16* qp = QRAW + myrow * 768 + h * 96 + 8 * hi;
        float f[6][8]; float ss = 0.f;
#pragma unroll
        for (int d0 = 0; d0 < 6; ++d0) { const v4u w = *(const v4u*)(qp + 16 * d0);
#pragma unroll
            for (int i = 0; i < 4; ++i) { f[d0][2 * i] = bflo(w[i]); f[d0][2 * i + 1] = bfhi(w[i]); ss += f[d0][2 * i] * f[d0][2 * i] + f[d0][2 * i + 1] * f[d0][2 * i + 1]; } }
        ss = swap_sum(ss);
        const float rq = RSQ[myrow];
        const float rn = rq * __builtin_amdgcn_rsqf(rq * rq * ss * (1.f / 96.f) + EPS);
#pragma unroll
        for (int d0 = 0; d0 < 6; ++d0) { const f32x4 g0 = *(const f32x4*)(a.q_head_g + 16 * d0 + 8 * hi), g1 = *(const f32x4*)(a.q_head_g + 16 * d0 + 8 * hi + 4);
#pragma unroll
            for (int i = 0; i < 4; ++i) { f[d0][i] *= rn * g0[i]; f[d0][4 + i] *= rn * g1[i]; } }
        const f32x2* csr = CS + myrow * 16 + 8 * hi;
#pragma unroll
        for (int j = 0; j < 8; ++j) { const f32x2 cs = csr[j]; const float x1 = f[4][j], x2 = f[5][j]; f[4][j] = x1 * cs.x - x2 * cs.y; f[5][j] = x2 * cs.x + x1 * cs.y; }
        float n2 = 0.f;
#pragma unroll
        for (int d0 = 0; d0 < 6; ++d0)
#pragma unroll
            for (int j = 0; j < 8; ++j) n2 += f[d0][j] * f[d0][j];
        n2 = swap_sum(n2);
        float gm_ = fabsf(a.k_head_g[lane]); if (lane < 32) gm_ = fmaxf(gm_, fabsf(a.k_head_g[64 + lane])); gm_ = wave_max(gm_);
        const float Mq = __builtin_sqrtf(n2) * gm_ * (9.797959f * 1.02f) * C2;
#pragma unroll
        for (int d0 = 0; d0 < 6; ++d0) { v4u w;
#pragma unroll
            for (int i = 0; i < 4; ++i) w[i] = pk2(f[d0][2 * i] * C2, f[d0][2 * i + 1] * C2);
            qr[d0] = __builtin_bit_cast(bf16x8, w); }
#pragma unroll
        for (int r = 0; r < 16; ++r) negm[r] = -Mq;
    }
    VM_WAIT();
    __builtin_amdgcn_sched_barrier(0);
    const bf16* ksrc = KF + (rowbase + lane) * 768 + h * 96 + 8 * wid;
    const bf16* vsrc = VF + (rowbase + 16 * (wid & 3) + (lane >> 2)) * 512 + h * 64 + (wid >> 2) * 32 + (lane & 3) * 8;
    const unsigned kdst = lds0 + L_K + wid * 1024, vdst = lds0 + L_V + wid * 1024;
#define DMA_TILE(t, sl) do { const bf16* ks_ = ksrc + (long)(t) * 64 * 768; \
        glds16(ks_, (unsigned)__builtin_amdgcn_readfirstlane(kdst + (sl) * KSLOT)); \
        if (wid < 4) glds16(ks_ + 64, (unsigned)__builtin_amdgcn_readfirstlane(kdst + (sl) * KSLOT + 8192)); \
        glds16(vsrc + (long)(t) * 64 * 512, (unsigned)__builtin_amdgcn_readfirstlane(vdst + (sl) * VSLOT)); } while (0)
    DMA_TILE(0, 0); DMA_TILE(1, 1);
    float lsum = 0.f; f32x16 o0 = {}, o1 = {};
    const LAS char* kp0 = (const LAS char*)shm3 + L_K + hi * 1024 + r32 * 16;
    const LAS char* vp0 = (const LAS char*)shm3 + L_V + ((lane >> 4) & 1) * 32 + (lane & 3) * 8 + (4 * hi + ((lane & 15) >> 2)) * 64;
    int slot = 0;
    for (int j = 0; j < NT; ++j) {
        if (j + 1 < NT) { if (wid < 4) asm volatile("s_waitcnt vmcnt(3)" ::: "memory"); else asm volatile("s_waitcnt vmcnt(2)" ::: "memory"); }
        else asm volatile("s_waitcnt vmcnt(0)" ::: "memory");
        asm volatile("s_waitcnt lgkmcnt(0)\n\ts_barrier" ::: "memory");
        if (j + 2 < NT) { const int s2 = (slot >= 1) ? slot - 1 : 2; DMA_TILE(j + 2, s2); }
        if (j < my_nt) {
            const LAS char* kp = kp0 + slot * KSLOT;
            f32x16 p0 = negm, p1 = negm;
#pragma unroll
            for (int d0 = 0; d0 < 6; ++d0) {
                const bf16x8 k0 = *(const LAS bf16x8*)(kp + d0 * 2048), k1 = *(const LAS bf16x8*)(kp + d0 * 2048 + 512);
                p0 = __builtin_amdgcn_mfma_f32_32x32x16_bf16(k0, qr[d0], p0, 0, 0, 0);
                p1 = __builtin_amdgcn_mfma_f32_32x32x16_bf16(k1, qr[d0], p1, 0, 0, 0);
            }
            float sacc = 0.f;
#pragma unroll
            for (int r = 0; r < 16; ++r) { p0[r] = fast_exp2(p0[r]); p1[r] = fast_exp2(p1[r]); sacc += p0[r] + p1[r]; }
            lsum += sacc;
            v4u pw[4];
#pragma unroll
            for (int i = 0; i < 4; ++i) { pw[0][i] = pk2(p0[2 * i], p0[2 * i + 1]); pw[1][i] = pk2(p0[8 + 2 * i], p0[9 + 2 * i]); pw[2][i] = pk2(p1[2 * i], p1[2 * i + 1]); pw[3][i] = pk2(p1[8 + 2 * i], p1[9 + 2 * i]); }
            const LAS char* vp = vp0 + slot * VSLOT;
#pragma unroll
            for (int ks = 0; ks < 4; ++ks) {
                const s16x4 l0 = vtr(vp + ks * 1024), h0 = vtr(vp + ks * 1024 + 512), l1 = vtr(vp + 4096 + ks * 1024), h1 = vtr(vp + 4096 + ks * 1024 + 512);
                const bf16x8 v0 = (bf16x8){l0[0], l0[1], l0[2], l0[3], h0[0], h0[1], h0[2], h0[3]}, v1 = (bf16x8){l1[0], l1[1], l1[2], l1[3], h1[0], h1[1], h1[2], h1[3]};
                const bf16x8 pa = __builtin_bit_cast(bf16x8, pw[ks]);
                o0 = __builtin_amdgcn_mfma_f32_32x32x16_bf16(pa, v0, o0, 0, 0, 0);
                o1 = __builtin_amdgcn_mfma_f32_32x32x16_bf16(pa, v1, o1, 0, 0, 0);
            }
        }
        slot = (slot == 2) ? 0 : slot + 1;
    }
#undef DMA_TILE
    lsum = swap_sum(lsum);
    LAS float* wsf = (LAS float*)(shm3 + L_WS) + wid * 64;
    if (hi == 0) wsf[r32] = lsum;
    LDS_WAIT();
    LAS bf16* stg = (LAS bf16*)(shm3 + L_OST) + wid * 2048;
#pragma unroll
    for (int r = 0; r < 16; ++r) { const int orow = crow(r, hi); const float rl = __builtin_amdgcn_rcpf(wsf[orow]);
        stg[orow * 64 + r32] = (bf16)(pk2(o0[r] * rl, 0.f) & 0xffffu); stg[orow * 64 + 32 + r32] = (bf16)(pk2(o1[r] * rl, 0.f) & 0xffffu); }
    LDS_WAIT();
    bf16* Ow = AO + (rowbase + q0 + wid * 32) * 512 + h * 64;
#pragma unroll
    for (int i = 0; i < 4; ++i) { const int row = i * 8 + (lane >> 3), ch = lane & 7; const v4u v = *(const LAS v4u*)(stg + row * 64 + ch * 8); *(v4u*)(Ow + (long)row * 512 + ch * 8) = v; }
    asm volatile("s_waitcnt lgkmcnt(0)\n\ts_barrier" ::: "memory");
}
}

__device__ __forceinline__ void p5_attn_norm(const Args& a, int vcu, int G, int wave, int lane) {
    const bf16* AO = (const bf16*)(a.ws + WS_AO); bf16* MIX = (bf16*)(a.ws + WS_MIX);
    const int c0 = 8 * lane; float g[8];
#pragma unroll
    for (int i = 0; i < 8; ++i) g[i] = a.attn_out_g[c0 + i];
    const int gw = vcu * 8 + wave, NGW = G * 8;
    for (int row = gw; row < T; row += NGW) {
        const v4u w = *(const v4u*)(AO + (size_t)row * 512 + c0);
        float f[8]; float ss = 0.f;
#pragma unroll
        for (int i = 0; i < 4; ++i) { f[2 * i] = bflo(w[i]); f[2 * i + 1] = bfhi(w[i]); ss += f[2 * i] * f[2 * i] + f[2 * i + 1] * f[2 * i + 1]; }
        const float r = __builtin_amdgcn_rsqf(wave_sum(ss) * (1.f / AW) + EPS);
        v4u o;
#pragma unroll
        for (int i = 0; i < 4; ++i) o[i] = pk2(f[2 * i] * r * g[2 * i], f[2 * i + 1] * r * g[2 * i + 1]);
        *(v4u*)(MIX + (size_t)row * 1024 + c0) = o;
    }
}

__device__ __forceinline__ void p7_router(const Args& a, LAS unsigned char* lds, int vcu, int G, int wave, int lane, int tid) {
    unsigned char* ws = a.ws;
    for (int i = tid; i < 8192; i += 512) ((LAS v4u*)lds)[i] = ((const v4u*)(ws + WS_RT))[i];
    LAS int* LCNT = (LAS int*)(lds + LCNT_OFF); LAS int* LBASE = (LAS int*)(lds + LBASE_OFF);
    gu32* gcnt = (gu32*)(ws + WS_CTL) + CW_CNT;
    int* POS = (int*)(ws + WS_POS); float* GWt = (float*)(ws + WS_GW); int* TOKL = (int*)(ws + WS_TOKL); float* RSL = (float*)(ws + WS_RSL);
    const int fr = lane & 15, kq = lane >> 4;
    for (int rnd = vcu; rnd < T / 128; rnd += G) {
        if (tid < 32) LCNT[tid] = 0;
        __syncthreads();
        const int t = rnd * 128 + wave * 16 + fr;
        const float* xr = a.out + (size_t)t * D + 8 * kq;
        f32x4 d0 = {0.f, 0.f, 0.f, 0.f}, d1 = {0.f, 0.f, 0.f, 0.f}; float ss = 0.f;
        const LAS char* rp = (const LAS char*)lds + (kq * 32 + fr) * 16;
#pragma unroll 4
        for (int s = 0; s < 32; ++s) {
            const f32x4 xa = *(const f32x4*)(xr + 32 * s), xb = *(const f32x4*)(xr + 32 * s + 4);
            ss += (xa[0] * xa[0] + xa[1] * xa[1]) + (xa[2] * xa[2] + xa[3] * xa[3]) + (xb[0] * xb[0] + xb[1] * xb[1]) + (xb[2] * xb[2] + xb[3] * xb[3]);
            v4u hw, lw;
            hw[0] = pk2(xa[0], xa[1]); hw[1] = pk2(xa[2], xa[3]); hw[2] = pk2(xb[0], xb[1]); hw[3] = pk2(xb[2], xb[3]);
            lw[0] = pk2(xa[0] - bflo(hw[0]), xa[1] - bfhi(hw[0])); lw[1] = pk2(xa[2] - bflo(hw[1]), xa[3] - bfhi(hw[1]));
            lw[2] = pk2(xb[0] - bflo(hw[2]), xb[1] - bfhi(hw[2])); lw[3] = pk2(xb[2] - bflo(hw[3]), xb[3] - bfhi(hw[3]));
            const bf16x8 xh = __builtin_bit_cast(bf16x8, hw), xl = __builtin_bit_cast(bf16x8, lw);
            const bf16x8 rh0 = *(const LAS bf16x8*)(rp + s * 2048), rh1 = *(const LAS bf16x8*)(rp + s * 2048 + 256);
            const bf16x8 rl0 = *(const LAS bf16x8*)(rp + 65536 + s * 2048), rl1 = *(const LAS bf16x8*)(rp + 65536 + s * 2048 + 256);
            d0 = __builtin_amdgcn_mfma_f32_16x16x32_bf16(rh0, xh, d0, 0, 0, 0); d1 = __builtin_amdgcn_mfma_f32_16x16x32_bf16(rh1, xh, d1, 0, 0, 0);
            d0 = __builtin_amdgcn_mfma_f32_16x16x32_bf16(rl0, xh, d0, 0, 0, 0); d1 = __builtin_amdgcn_mfma_f32_16x16x32_bf16(rl1, xh, d1, 0, 0, 0);
            d0 = __builtin_amdgcn_mfma_f32_16x16x32_bf16(rh0, xl, d0, 0, 0, 0); d1 = __builtin_amdgcn_mfma_f32_16x16x32_bf16(rh1, xl, d1, 0, 0, 0);
        }
        ss += __shfl_xor(ss, 16); ss += __shfl_xor(ss, 32);
        const float rstd = __builtin_amdgcn_rsqf(ss * (1.f / D) + EPS);
        float lg[32];
#pragma unroll
        for (int q = 0; q < 4; ++q)
#pragma unroll
            for (int r = 0; r < 4; ++r) { lg[4 * q + r] = __shfl(d0[r], fr + 16 * q) * rstd + a.router_b[4 * q + r]; lg[16 + 4 * q + r] = __shfl(d1[r], fr + 16 * q) * rstd + a.router_b[16 + 4 * q + r]; }
        unsigned taken = 0u; float tv[4]; int ti[4];
#pragma unroll
        for (int k = 0; k < 4; ++k) { float best = -INFINITY; int bi = 0;
#pragma unroll
            for (int e = 0; e < 32; ++e) { const bool ok = !((taken >> e) & 1u) && (lg[e] > best); best = ok ? lg[e] : best; bi = ok ? e : bi; }
            tv[k] = best; ti[k] = bi; taken |= 1u << bi; }
        float ex[4], es = 0.f;
#pragma unroll
        for (int k = 0; k < 4; ++k) { ex[k] = __expf(tv[k] - tv[0]); es += ex[k]; }
        const float ies = 1.f / es;
        int rank[4];
        if (kq == 0) {
#pragma unroll
            for (int k = 0; k < 4; ++k) rank[k] = __hip_atomic_fetch_add(LCNT + ti[k], 1, __ATOMIC_RELAXED, __HIP_MEMORY_SCOPE_WORKGROUP);
        }
        __syncthreads();
        if (tid < 32) { const int c = LCNT[tid]; int base = 0; if (c > 0) base = (int)__hip_atomic_fetch_add(gcnt + 64 * tid, (unsigned)c, __ATOMIC_RELAXED, __HIP_MEMORY_SCOPE_AGENT); LBASE[tid] = base; }
        __syncthreads();
        if (kq == 0) {
#pragma unroll
            for (int k = 0; k < 4; ++k) { const int e = ti[k]; const int sl = LBASE[e] + rank[k];
                TOKL[(size_t)e * T + sl] = t; RSL[(size_t)e * T + sl] = rstd; POS[t * 4 + k] = (e << 16) | sl; GWt[t * 4 + k] = ex[k] * ies; }
        }
        __syncthreads();
    }
}

__device__ __forceinline__ void moe_tables(const Args& a, LAS unsigned char* lds, int tid) {
    LAS int* TS = (LAS int*)(lds + TS_OFF); LAS int* EC = (LAS int*)(lds + ECNT_OFF);
    const gu32* gcnt = (const gu32*)(a.ws + WS_CTL) + CW_CNT;
    if (tid == 0) { int acc = 0; for (int e = 0; e < NE; ++e) { const int c = (int)__hip_atomic_load(gcnt + 64 * e, __ATOMIC_RELAXED, __HIP_MEMORY_SCOPE_AGENT); EC[e] = c; TS[e] = acc; acc += (c + 255) >> 8; } TS[NE] = acc; }
    __syncthreads();
}

__device__ __forceinline__ void p10_combine(const Args& a, LAS unsigned char* lds, int vcu, int G, int wave, int lane) {
    const LAS int* TS = (const LAS int*)(lds + TS_OFF);
    const int* POS = (const int*)(a.ws + WS_POS); const float* GWt = (const float*)(a.ws + WS_GW); const bf16* YS = (const bf16*)(a.ws + WS_YS);
    const int gw = vcu * 8 + wave, NGW = G * 8;
    for (int t = gw; t < T; t += NGW) {
        float* orow = a.out + (size_t)t * D;
        f32x4 v[2][2];
#pragma unroll
        for (int j = 0; j < 2; ++j) { v[j][0] = *(const f32x4*)(orow + 512 * j + 8 * lane); v[j][1] = *(const f32x4*)(orow + 512 * j + 8 * lane + 4); }
#pragma unroll
        for (int k = 0; k < 4; ++k) { const int p = POS[t * 4 + k]; const float w = GWt[t * 4 + k]; const int e = p >> 16, sl = p & 0xffff;
            const bf16* yr = YS + ((size_t)TS[e] * 256 + sl) * 1024;
#pragma unroll
            for (int j = 0; j < 2; ++j) { const v4u y = *(const v4u*)(yr + 512 * j + 8 * lane);
                v[j][0][0] += w * bflo(y[0]); v[j][0][1] += w * bfhi(y[0]); v[j][0][2] += w * bflo(y[1]); v[j][0][3] += w * bfhi(y[1]);
                v[j][1][0] += w * bflo(y[2]); v[j][1][1] += w * bfhi(y[2]); v[j][1][2] += w * bflo(y[3]); v[j][1][3] += w * bfhi(y[3]); } }
#pragma unroll
        for (int j = 0; j < 2; ++j) { *(f32x4*)(orow + 512 * j + 8 * lane) = v[j][0]; *(f32x4*)(orow + 512 * j + 8 * lane + 4) = v[j][1]; }
    }
}

__global__ void __launch_bounds__(512, 2) mk_fwd(Args args) {
    extern __shared__ __attribute__((aligned(16))) unsigned char lds_raw[];
    LAS unsigned char* lds = (LAS unsigned char*)lds_raw;
    const int tid = threadIdx.x, lane = tid & 63, wave = __builtin_amdgcn_readfirstlane(tid >> 6);
    const int G = gridDim.x; const int bx = blockIdx.x; const int vcu = (G % 8 == 0) ? (bx % 8) * (G / 8) + bx / 8 : bx;
    unsigned char* ws = args.ws;
    for (int u = tid; u < (LDS_BYTES - MISC_OFF) / 4; u += 512) ((LAS unsigned*)(lds + MISC_OFF))[u] = 0u;
    __syncthreads();
    gu32* ctl = (gu32*)(ws + WS_CTL);
#if MK_PER_PHASE
#define GRID_BAR() do { } while (0)
#else
    XcdBarrier bar = xcd_barrier_post((unsigned*)ctl + CW_BAR, (volatile LAS unsigned*)(lds + MISC_OFF));
#define GRID_BAR() xcd_barrier(bar)
#endif
    const int lo = args.ph_lo, hi = args.ph_hi;
#define IN(k) (lo <= (k) && (k) < hi)
#define BOTH(k) (IN(k) && IN((k) + 1))

    if (IN(0)) { p0_prologue(args, lds, vcu, G, wave, lane, tid); if (BOTH(0)) GRID_BAR(); }

    if (IN(1)) {
        gm::DenseSched Sd; Sd.init(ws + WS_H1, ws + WS_WIN, T, NIN1, 1024, 1024, G, bx);
        gm::EpiIn E{(bf16*)(ws + WS_CQKV), (bf16*)(ws + WS_Y), (float*)(ws + WS_KPE)};
        gm::gemm_phase(lds, Sd, E);
        if (BOTH(1)) GRID_BAR();
    }
    if (IN(2)) { p2_thin(args, lds, vcu, G, wave, lane, tid); if (BOTH(2)) GRID_BAR(); }

    if (IN(3)) {
        { gm::DenseSched Sd; Sd.init(ws + WS_CQKV, ws + WS_WUQ, T, 768, QL, 512, G, bx);
          gm::EpiPlain E{(bf16*)(ws + WS_QRAW), 768};
          gm::gemm_phase(lds, Sd, E); }
        { gm::DenseSched Sd; Sd.init(ws + WS_CQKV + QL * 2, ws + WS_WUKV, T, 1024, KVL, 512, G, bx);
          gm::EpiKV E{(bf16*)(ws + WS_KF), (bf16*)(ws + WS_VF), (const float*)(ws + WS_RSKV), (const float*)(ws + WS_KSS), (const float*)(ws + WS_KR), args.k_head_g};
          gm::gemm_phase(lds, Sd, E); }
        if (BOTH(3)) GRID_BAR();
    }
    if (IN(4)) {
        for (int v = vcu; v < 256; v += G) {
            const int bh = v >> 2, j = v & 3;
            for (int i = 0; i < 4; ++i) { const int qb = (i == 0) ? j : (i == 1) ? 15 - j : (i == 2) ? 4 + j : 11 - j; at::attn_unit(args, bh >> 3, bh & 7, qb, lds); }
        }
        if (BOTH(4)) GRID_BAR();
    }
    if (IN(5)) { p5_attn_norm(args, vcu, G, wave, lane); if (BOTH(5)) GRID_BAR(); }

    if (IN(6)) {
        gm::DenseSched Sd; Sd.init(ws + WS_MIX, ws + WS_WOUT, T, 1024, 1024, 1024, G, bx);
        gm::EpiX1 E{args.x, args.out, (bf16*)(ws + WS_X1B)};
        gm::gemm_phase(lds, Sd, E);
        if (BOTH(6)) GRID_BAR();
    }
    if (IN(7)) { p7_router(args, lds, vcu, G, wave, lane, tid); if (BOTH(7)) GRID_BAR(); }

    if (IN(8) || IN(9) || IN(10)) moe_tables(args, lds, tid);
    const int ngrp = (G % 8 == 0) ? 8 : 1, cpg = G / ngrp, epg = NE / ngrp;
    if (IN(8)) {
        gm::MoeSched<true> Sm{(const char*)(ws + WS_X1B), (const char*)(ws + WS_WGU), 1024, 1024, 2048, 8, (const int*)(ws + WS_TOKL), (const LAS int*)(lds + TS_OFF), (const LAS int*)(lds + ECNT_OFF), vcu / cpg, vcu % cpg, cpg, epg};
        gm::EpiGU E{(bf16*)(ws + WS_ACT), args.b_gate_up, (const float*)(ws + WS_RSL), (const LAS int*)(lds + ECNT_OFF)};
        gm::gemm_phase(lds, Sm, E);
        if (BOTH(8)) GRID_BAR();
    }
    if (IN(9)) {
        gm::MoeSched<false> Sm{(const char*)(ws + WS_ACT), (const char*)(ws + WS_WD), 1024, 1024, 1024, 4, nullptr, (const LAS int*)(lds + TS_OFF), (const LAS int*)(lds + ECNT_OFF), vcu / cpg, vcu % cpg, cpg, epg};
        gm::EpiDown E{(bf16*)(ws + WS_YS), args.b_down};
        gm::gemm_phase(lds, Sm, E);
        if (BOTH(9)) GRID_BAR();
    }
    if (IN(10)) { p10_combine(args, lds, vcu, G, wave, lane); }
#undef IN
#undef BOTH
}

extern "C" void kernel_launch(void* const* d_in, const int* in_sizes, int n_in, void* d_out, int out_size, void* d_ws, size_t ws_size, hipStream_t stream) {
    static int grid = 0;
    if (grid == 0) {
        if (n_in != 24 || in_sizes[0] != T * D || out_size != T * D || ws_size < WS_END) { fprintf(stderr, "kernel_launch: unexpected shapes (n_in %d, in0 %d, out %d, ws %zu < %zu)\n", n_in, n_in > 0 ? in_sizes[0] : -1, out_size, ws_size, (size_t)WS_END); grid = -1; return; }
        int dev = 0, cus = 0, per_cu = 0;
        if (hipGetDevice(&dev) != hipSuccess || hipDeviceGetAttribute(&cus, hipDeviceAttributeMultiprocessorCount, dev) != hipSuccess) { fprintf(stderr, "kernel_launch: device query failed\n"); grid = -1; return; }
        if (hipFuncSetAttribute((const void*)mk_fwd, hipFuncAttributeMaxDynamicSharedMemorySize, LDS_BYTES) != hipSuccess) { fprintf(stderr, "kernel_launch: hipFuncSetAttribute failed\n"); grid = -1; return; }
        if (hipOccupancyMaxActiveBlocksPerMultiprocessor(&per_cu, (const void*)mk_fwd, 512, LDS_BYTES) != hipSuccess || per_cu < 1) fprintf(stderr, "kernel_launch: occupancy query says %d\n", per_cu);
        (void)hipGetLastError();
        grid = cus;
    }
    if (grid < 0) return;
    if (hipMemsetAsync((char*)d_ws + WS_CTL, 0, CTL_ZERO_BYTES, stream) != hipSuccess) { fprintf(stderr, "kernel_launch: memset failed\n"); return; }
    Args a{};
    a.x = (const float*)d_in[0]; a.positions = (const int*)d_in[1]; a.norm_mix_g = (const float*)d_in[2]; a.w_in = (const float*)d_in[3]; a.q_latent_g = (const float*)d_in[4]; a.w_uq = (const float*)d_in[5];
    a.kv_latent_g = (const float*)d_in[6]; a.w_ukv = (const float*)d_in[7]; a.q_head_g = (const float*)d_in[8]; a.k_head_g = (const float*)d_in[9]; a.conv_dw_w = (const float*)d_in[10]; a.conv_dw_b = (const float*)d_in[11];
    a.conv_ln_g = (const float*)d_in[12]; a.conv_ln_b = (const float*)d_in[13]; a.attn_out_g = (const float*)d_in[14]; a.conv_out_g = (const float*)d_in[15]; a.w_out = (const float*)d_in[16]; a.norm_ffn_g = (const float*)d_in[17];
    a.router_w = (const float*)d_in[18]; a.router_b = (const float*)d_in[19]; a.w_gate_up = (const float*)d_in[20]; a.b_gate_up = (const float*)d_in[21]; a.w_down = (const float*)d_in[22]; a.b_down = (const float*)d_in[23];
    a.out = (float*)d_out; a.ws = (unsigned char*)d_ws;
#if MK_PER_PHASE
    for (int p = 0; p < NPH; ++p) { a.ph_lo = p; a.ph_hi = p + 1; hipLaunchKernelGGL(mk_fwd, dim3(grid), dim3(512), LDS_BYTES, stream, a); }
#else
    a.ph_lo = 0; a.ph_hi = NPH; hipLaunchKernelGGL(mk_fwd, dim3(grid), dim3(512), LDS_BYTES, stream, a);
#endif
    const hipError_t le = hipPeekAtLastError();
    if (le != hipSuccess) fprintf(stderr, "kernel_launch: launch failed: %s\n", hipGetErrorName(le));
}
```

```cpp
#include <hip/hip_runtime.h>
#include <cstdio>
#include <cstdint>

#ifndef MK_PER_PHASE
#define MK_PER_PHASE 0
#endif

#define GAS __attribute__((address_space(1)))
#define LAS __attribute__((address_space(3)))
typedef unsigned short bf16;
typedef unsigned v4u __attribute__((ext_vector_type(4)));
typedef unsigned v2u __attribute__((ext_vector_type(2)));
typedef float f32x4 __attribute__((ext_vector_type(4)));
typedef float f32x2 __attribute__((ext_vector_type(2)));
typedef float f32x16 __attribute__((ext_vector_type(16)));
typedef short bf16x8 __attribute__((ext_vector_type(8)));
typedef short s16x4 __attribute__((ext_vector_type(4)));
typedef __bf16 bf16x2_t __attribute__((ext_vector_type(2)));
typedef GAS unsigned gu32;

constexpr int NB = 8, S = 4096, T = NB * S, D = 1024;
constexpr int NH = 8, DQK = 96, DV = 64;
constexpr int QL = 384, KVL = 128, CW = 512, AW = 512, CK = 31, INW = 1568;
constexpr int NE = 32, DFF = 1024;
constexpr float EPS = 1e-6f;
constexpr int NIN1 = 1792;
constexpr int MAXSLOT = T * 4 + NE * 256;
constexpr float C2 = 0.14724445f;
constexpr int NPH = 11;

constexpr size_t MiB = 1u << 20;
constexpr size_t WS_CTL = 0, CTL_ZERO_BYTES = 1 * MiB;
constexpr size_t WS_WIN = 2 * MiB, WS_WUQ = 6 * MiB, WS_WUKV = 7 * MiB, WS_WOUT = 8 * MiB, WS_RT = 10 * MiB, WS_CS = 12 * MiB;
constexpr size_t WS_RSQ = 16 * MiB, WS_RSKV = WS_RSQ + 128 * 1024, WS_KSS = WS_RSKV + 128 * 1024;
constexpr size_t WS_KR = 17 * MiB, WS_POS = 21 * MiB, WS_GW = WS_POS + 512 * 1024, WS_TOKL = 22 * MiB, WS_RSL = 26 * MiB;
constexpr size_t WS_WGU = 32 * MiB, WS_WD = 160 * MiB, WS_H1 = 224 * MiB, WS_CQKV = 288 * MiB, WS_Y = 320 * MiB, WS_KPE = 352 * MiB;
constexpr size_t WS_QRAW = 356 * MiB, WS_KF = 404 * MiB, WS_VF = 452 * MiB, WS_AO = 484 * MiB, WS_MIX = 516 * MiB, WS_X1B = 580 * MiB, WS_ACT = 644 * MiB;
constexpr size_t WS_YS = 224 * MiB;
constexpr size_t WS_END = 916 * MiB;
static_assert(WS_ACT + (size_t)MAXSLOT * 1024 * 2 <= WS_END && WS_YS + (size_t)MAXSLOT * 1024 * 2 <= WS_MIX, "ws map");
constexpr int CW_TMO = 0, CW_BAR = 4096, CW_CNT = 8192;

constexpr int RING_BYTES = 131072;
constexpr int MISC_OFF = RING_BYTES;
constexpr int LCNT_OFF = MISC_OFF + 64;
constexpr int LBASE_OFF = LCNT_OFF + 128;
constexpr int TS_OFF = LBASE_OFF + 128;
constexpr int ECNT_OFF = TS_OFF + 160;
constexpr int LDS_BYTES = 147456;

#define LDS_WAIT() asm volatile("s_waitcnt lgkmcnt(0)" ::: "memory")
#define VM_WAIT() asm volatile("s_waitcnt vmcnt(0)" ::: "memory")

__device__ __forceinline__ unsigned pk2(float lo, float hi) { f32x2 v = {lo, hi}; bf16x2_t b = __builtin_convertvector(v, bf16x2_t); return __builtin_bit_cast(unsigned, b); }
__device__ __forceinline__ float bflo(unsigned w) { return __builtin_bit_cast(float, w << 16); }
__device__ __forceinline__ float bfhi(unsigned w) { return __builtin_bit_cast(float, w & 0xffff0000u); }
__device__ __forceinline__ float wave_sum(float v) {
#pragma unroll
    for (int o = 1; o < 64; o <<= 1) v += __shfl_xor(v, o);
    return v;
}
__device__ __forceinline__ float wave_max(float v) {
#pragma unroll
    for (int o = 1; o < 64; o <<= 1) v = fmaxf(v, __shfl_xor(v, o));
    return v;
}
__device__ __forceinline__ float swap_sum(float v) { auto rr = __builtin_amdgcn_permlane32_swap(__float_as_uint(v), __float_as_uint(v), false, false); return __uint_as_float(rr[0]) + __uint_as_float(rr[1]); }
__device__ __forceinline__ float fast_exp2(float x) { return __builtin_amdgcn_exp2f(x); }
__device__ __forceinline__ float sigmoidf_(float g) { return __builtin_amdgcn_rcpf(1.f + fast_exp2(-1.4426950408889634f * g)); }

#define XB_TMO      128
#define XB_XCNT(j)  (256  + 64 * (j))
#define XB_XSUB(j)  (1280 + 64 * (j))
#define XB_XGEN(j)  (2304 + 64 * (j))
#define XB_TOP      3328
#define XB_TOPGEN   3392
#define XCD_BAR_WORDS 3456
#define XB_SPIN_CAP (1u << 18)
__device__ __forceinline__ unsigned xb_ld(unsigned* p)              { return __hip_atomic_load(p, __ATOMIC_RELAXED, __HIP_MEMORY_SCOPE_AGENT); }
__device__ __forceinline__ unsigned xb_add(unsigned* p, unsigned v) { return __hip_atomic_fetch_add(p, v, __ATOMIC_RELAXED, __HIP_MEMORY_SCOPE_AGENT); }
__device__ __forceinline__ unsigned xb_xcc_id() { return (unsigned)__builtin_amdgcn_s_getreg((3 << 11) | 20) & 0xFu; }
#define XB_SPIN(cond, bar) do { unsigned _sp = 0; while (cond) { __builtin_amdgcn_s_sleep(1); \
    if ((++_sp & 255u) == 0u) { if (xb_ld(&(bar)[XB_TMO])) break; if (_sp > XB_SPIN_CAP) { atomicAdd(&(bar)[XB_TMO], 1u); break; } } } } while (0)
struct XcdBarrier { unsigned* bar; unsigned x; volatile LAS unsigned* st; };
__device__ __forceinline__ XcdBarrier xcd_barrier_post(unsigned* bar, volatile LAS unsigned* st) {
    XcdBarrier b; b.bar = bar; b.x = xb_xcc_id(); b.st = st;
    if (threadIdx.x == 0) (void)xb_add(&bar[XB_XCNT(b.x)], 1u);
    return b;
}
__device__ __forceinline__ void xcd_barrier_complete(unsigned* bar, unsigned x, unsigned& nloc, unsigned& nx) {
    const unsigned G = gridDim.x * gridDim.y * gridDim.z;
    unsigned sum, cnt, mine, sp = 0u;
    for (;;) {
        sum = 0u; cnt = 0u; mine = 0u;
#pragma unroll
        for (unsigned j = 0; j < 16; ++j) { const unsigned c = xb_ld(&bar[XB_XCNT(j)]); sum += c; cnt += (c > 0u) ? 1u : 0u; mine = (j == x) ? c : mine; }
        if (sum == G) break;
        __builtin_amdgcn_s_sleep(1);
        if ((++sp & 255u) == 0u) { if (xb_ld(&bar[XB_TMO])) break; if (sp > XB_SPIN_CAP) { atomicAdd(&bar[XB_TMO], 1u); break; } }
    }
    nloc = mine > 0u ? mine : 1u; nx = cnt > 0u ? cnt : 1u;
}
__device__ __forceinline__ void xcd_barrier(const XcdBarrier& b) {
    asm volatile("s_waitcnt vmcnt(0)" ::: "memory");
    __syncthreads();
    if (threadIdx.x == 0) {
        unsigned* bar = b.bar;
        __builtin_amdgcn_s_waitcnt(0);
        unsigned nloc = b.st[0], nx = b.st[1];
        if (nloc == 0u) { xcd_barrier_complete(bar, b.x, nloc, nx); b.st[0] = nloc; b.st[1] = nx; }
        const unsigned old = xb_add(&bar[XB_XSUB(b.x)], 1u);
        const unsigned gen = old / nloc;
        if (old + 1u == (gen + 1u) * nloc) {
            __builtin_amdgcn_fence(__ATOMIC_RELEASE, "agent");
            asm volatile("s_waitcnt vmcnt(0)" ::: "memory");
            const unsigned og = xb_add(&bar[XB_TOP], 1u);
            const unsigned tg = og / nx;
            if (og + 1u == (tg + 1u) * nx) xb_add(&bar[XB_TOPGEN], 1u);
            else XB_SPIN(xb_ld(&bar[XB_TOPGEN]) == tg, bar);
            __builtin_amdgcn_fence(__ATOMIC_ACQUIRE, "agent");
            xb_add(&bar[XB_XGEN(b.x)], 1u);
            asm volatile("s_waitcnt vmcnt(0)" ::: "memory");
        } else {
            XB_SPIN(xb_ld(&bar[XB_XGEN(b.x)]) == gen, bar);
            __builtin_amdgcn_fence(__ATOMIC_ACQUIRE, "agent");
            asm volatile("s_waitcnt vmcnt(0)" ::: "memory");
        }
    }
    __syncthreads();
}

namespace gm {
constexpr int BM = 256, BK = 64, HALF = 128, HTB = HALF * BK * 2, NXCD = 8, WGM = 8;
__host__ __device__ __forceinline__ int lds_byte(int r, int c) { const int st = (r >> 4) * 2 + (c >> 5), rr = r & 15, cc = c & 31, ob = rr * 64 + cc * 2; return st * 1024 + (ob ^ (((ob >> 9) & 1) << 5)); }
__host__ __device__ __forceinline__ void stage_rc(int b, int& R, int& C) { const int st = b / 1024, sb = b % 1024, swz = sb ^ (((sb >> 9) & 1) << 5); R = (st >> 1) * 16 + swz / 64; C = (st & 1) * 32 + (swz % 64) / 2; }
__host__ __device__ __forceinline__ int perm32(int rho) { const int n = rho >> 4, i = rho & 15; return 8 * (i >> 2) + 4 * n + (i & 3); }

struct Unit { int pm, pn, e, rt; };

struct DenseSched {
    const char* A; const char* Bt; int K, lda;
    int nM, nN, nwg, G, c;
    __device__ __forceinline__ void init(const void* A_, const void* Bt_, int M, int N, int K_, int lda_, int G_, int c_) { A = (const char*)A_; Bt = (const char*)Bt_; K = K_; lda = lda_; nM = M / BM; nN = N / BM; nwg = nM * nN; G = G_; c = c_; }
    __device__ __forceinline__ bool next(int i, Unit& u) const {
        const long L = (long)i * G + c; if (L >= nwg) return false;
        int wgid = (int)L; { const int q = nwg / NXCD, r = nwg % NXCD, xcd = wgid % NXCD, off = wgid / NXCD; wgid = (xcd < r ? xcd * (q + 1) : r * (q + 1) + (xcd - r) * q) + off; }
        const int nig = WGM * nN, gid = wgid / nig, fm = gid * WGM, gsz = (nM - fm) < WGM ? (nM - fm) : WGM;
        u.pm = fm + ((wgid % nig) % gsz); u.pn = (wgid % nig) / gsz; u.e = 0; u.rt = u.pm; return true;
    }
    __device__ __forceinline__ const char* b_tile(const Unit& u) const { return Bt + (size_t)u.pn * BM * K * 2; }
    static constexpr bool GATHER = false;
    __device__ __forceinline__ const char* a_tile(const Unit& u) const { return A + (size_t)u.pm * BM * lda * 2; }
    __device__ __forceinline__ void a_off(const Unit&, const int (&)[2], const int (&)[2], unsigned (&)[2][2]) const {}
};
template <bool GATH> struct MoeSched {
    static constexpr bool GATHER = GATH;
    const char* A; const char* Bt; int K, lda, N;
    int nct;
    const int* tokl;
    const LAS int* TS; const LAS int* EC;
    int grp, rank, cpg, epg;
    __device__ __forceinline__ bool next(int i, Unit& u) const {
        int L = i * cpg + rank;
        for (int q = 0; q < epg; ++q) {
            const int e = grp * epg + q; const int nt_e = __builtin_amdgcn_readfirstlane(TS[e + 1] - TS[e]); const int nu = nt_e * nct;
            if (L < nu) { u.e = e; u.rt = L / nct; u.pn = L % nct; u.pm = __builtin_amdgcn_readfirstlane(TS[e]) + u.rt; return true; }
            L -= nu;
        }
        return false;
    }
    __device__ __forceinline__ const char* b_tile(const Unit& u) const { return Bt + ((size_t)u.e * N + (size_t)u.pn * BM) * K * 2; }
    __device__ __forceinline__ const char* a_tile(const Unit& u) const { return A + (size_t)u.pm * BM * lda * 2; }
    __device__ __forceinline__ void a_off(const Unit& u, const int (&R)[2], const int (&C)[2], unsigned (&off)[2][2]) const {
        const int cnt = EC[u.e];
#pragma unroll
        for (int h = 0; h < 2; ++h)
#pragma unroll
            for (int i = 0; i < 2; ++i) { const int sl = u.rt * BM + h * HALF + R[i]; const int tok = (sl < cnt) ? tokl[(size_t)u.e * T + sl] : 0; off[h][i] = (unsigned)(((size_t)tok * lda + C[i]) * 2); }
    }
};

template <class Epi, class Sched>
__device__ __forceinline__ void gemm_phase(LAS unsigned char* lds, const Sched& S, const Epi& E) {
    const int tid = threadIdx.x, wid = __builtin_amdgcn_readfirstlane(tid >> 6), lane = tid & 63, wr = wid >> 2, wc = wid & 3, fr = lane & 15, fq = lane >> 4;
    const int K = S.K, nt = K / BK;
    int R[2], C[2]; unsigned voffB[2];
#pragma unroll
    for (int i = 0; i < 2; ++i) { stage_rc(tid * 16 + i * 8192, R[i], C[i]); const int Rb = (R[i] & ~31) + perm32(R[i] & 31); voffB[i] = (unsigned)(Rb * K + C[i]) * 2u; }
    const size_t kstep = (size_t)(BK * 2);
    const size_t hstepB = (size_t)HALF * K * 2;
    const unsigned ldsw = (unsigned)wid * 1024u;
    const int aoff = lds_byte(wr * 64 + fr, fq * 8), boff = lds_byte(wc * 32 + fr, fq * 8);
#define G_SA(b, h) (((b) * 2 + (h)) * HTB)
#define G_SB(b, h) ((4 + (b) * 2 + (h)) * HTB)
#define G_STAGE(bufoff, gbase, o0, o1) do { \
        __builtin_amdgcn_global_load_lds((const unsigned*)((const char*)(gbase) + (o0)), (LAS unsigned*)(lds + (bufoff) + ldsw), 16, 0, 0); \
        __builtin_amdgcn_global_load_lds((const unsigned*)((const char*)(gbase) + (o1)), (LAS unsigned*)(lds + (bufoff) + ldsw + 8192), 16, 0, 0); } while (0)
#define G_LDA(dst, b, h) do { _Pragma("unroll") for (int m = 0; m < 4; ++m) _Pragma("unroll") for (int k = 0; k < 2; ++k) dst[m][k] = *(const LAS bf16x8*)(lds + G_SA(b, h) + aoff + m * 2048 + k * 1024); } while (0)
#define G_LDB(dst, b, h) do { _Pragma("unroll") for (int n = 0; n < 2; ++n) _Pragma("unroll") for (int k = 0; k < 2; ++k) dst[n][k] = *(const LAS bf16x8*)(lds + G_SB(b, h) + boff + n * 2048 + k * 1024); } while (0)
#define G_MMA(ai, bj, At, Bt) do { __builtin_amdgcn_s_setprio(1); _Pragma("unroll") for (int m = 0; m < 4; ++m) _Pragma("unroll") for (int n = 0; n < 2; ++n) _Pragma("unroll") for (int k = 0; k < 2; ++k) \
        acc[ai][bj][m][n] = __builtin_amdgcn_mfma_f32_16x16x32_bf16(Bt[n][k], At[m][k], acc[ai][bj][m][n], 0, 0, 0); __builtin_amdgcn_s_setprio(0); } while (0)
#define G_WAIT_V(n) asm volatile("s_waitcnt vmcnt(" #n ")" ::: "memory")
#define G_WAIT_L(n) asm volatile("s_waitcnt lgkmcnt(" #n ")" ::: "memory")
#define G_BAR __builtin_amdgcn_s_barrier()
#define G_SCHED __builtin_amdgcn_sched_barrier(0)
    Unit cur, nxt; int ui = 0;
    if (!S.next(0, cur)) return;
    f32x4 acc[2][2][4][2];
#pragma unroll
    for (int a = 0; a < 2; ++a)
#pragma unroll
        for (int b = 0; b < 2; ++b)
#pragma unroll
            for (int m = 0; m < 4; ++m)
#pragma unroll
                for (int n = 0; n < 2; ++n) acc[a][b][m][n] = (f32x4){0.f, 0.f, 0.f, 0.f};
    bf16x8 At[4][2], B0[2][2], B1[2][2];
    unsigned off[2][2], noff[2][2]; unsigned voffA[2];
    const size_t hstepA = (size_t)HALF * S.lda * 2;
    const char* cA = S.A; const char* nA = S.A;
    if constexpr (Sched::GATHER) { S.a_off(cur, R, C, off); voffA[0] = voffA[1] = 0u; }
    else { cA = S.a_tile(cur); voffA[0] = (unsigned)(R[0] * S.lda + C[0]) * 2u; voffA[1] = (unsigned)(R[1] * S.lda + C[1]) * 2u; off[0][0] = off[0][1] = off[1][0] = off[1][1] = 0u; noff[0][0] = noff[0][1] = noff[1][0] = noff[1][1] = 0u; }
#define G_STAGE_A(bufoff, h, ktb, NX) do { \
        if constexpr (Sched::GATHER) { G_STAGE(bufoff, cA + (ktb), (NX) ? noff[h][0] : off[h][0], (NX) ? noff[h][1] : off[h][1]); } \
        else { G_STAGE(bufoff, ((NX) ? nA : cA) + (h) * hstepA + (ktb), voffA[0], voffA[1]); } } while (0)
    const char* cB = S.b_tile(cur);
    G_STAGE(G_SB(0, 0), cB, voffB[0], voffB[1]); G_STAGE(G_SB(0, 1), cB + hstepB, voffB[0], voffB[1]); G_STAGE_A(G_SA(0, 0), 0, 0, false); G_STAGE_A(G_SA(0, 1), 1, 0, false);
    if (wr == 1) G_BAR;
    G_WAIT_V(2); G_BAR;
    G_STAGE(G_SB(1, 0), cB + kstep, voffB[0], voffB[1]); G_STAGE_A(G_SA(1, 0), 0, kstep, false); G_STAGE(G_SB(1, 1), cB + hstepB + kstep, voffB[0], voffB[1]);
    G_WAIT_V(6); G_BAR;
    for (;;) {
        const bool has_next = S.next(ui + 1, nxt);
        if constexpr (Sched::GATHER) { if (has_next) S.a_off(nxt, R, C, noff); else { noff[0][0] = off[0][0]; noff[0][1] = off[0][1]; noff[1][0] = off[1][0]; noff[1][1] = off[1][1]; } }
        else nA = has_next ? S.a_tile(nxt) : cA;
        const char* nB = has_next ? S.b_tile(nxt) : cB;
        for (int t = 0; t < nt; t += 2) {
            const bool last = (t == nt - 2);
            const size_t k1 = (size_t)(t + 1) * kstep;
            const size_t k2 = last ? 0 : (size_t)(t + 2) * kstep, k3 = k2 + kstep;
            const char* b2 = last ? nB : cB + (size_t)(t + 2) * kstep; const char* b3 = b2 + kstep;
            G_LDB(B0, 0, 0); G_LDB(B1, 0, 1); G_SCHED; G_LDA(At, 0, 0); G_STAGE_A(G_SA(1, 1), 1, k1, false);
            G_WAIT_V(8); G_WAIT_L(0); G_BAR; G_MMA(0, 0, At, B0); G_MMA(0, 1, At, B1); G_BAR; G_SCHED;
            G_LDA(At, 0, 1); G_STAGE(G_SB(0, 0), b2, voffB[0], voffB[1]); G_STAGE(G_SB(0, 1), b2 + hstepB, voffB[0], voffB[1]); G_STAGE_A(G_SA(0, 0), 0, k2, last);
            G_WAIT_V(8); G_WAIT_L(0); G_BAR; G_MMA(1, 0, At, B0); G_MMA(1, 1, At, B1); G_BAR; G_SCHED;
            G_LDB(B0, 1, 0); G_LDB(B1, 1, 1); G_SCHED; G_LDA(At, 1, 0); G_STAGE_A(G_SA(0, 1), 1, k2, last);
            G_WAIT_V(8); G_WAIT_L(0); G_BAR; G_MMA(0, 0, At, B0); G_MMA(0, 1, At, B1); G_BAR; G_SCHED;
            G_LDA(At, 1, 1); G_STAGE(G_SB(1, 0), b3, voffB[0], voffB[1]); G_STAGE(G_SB(1, 1), b3 + hstepB, voffB[0], voffB[1]); G_STAGE_A(G_SA(1, 0), 0, k3, last);
            G_WAIT_V(8); G_WAIT_L(0); G_BAR; G_MMA(1, 0, At, B0); G_MMA(1, 1, At, B1); G_BAR; G_SCHED;
        }
        if (wr == 0) G_BAR;
        { int fr_e = fr, fq_e = fq; asm volatile("" : "+v"(fr_e), "+v"(fq_e));
          E(acc, cur, wr, wc, fr_e, fq_e); }
        if (!has_next) break;
#pragma unroll
        for (int a = 0; a < 2; ++a)
#pragma unroll
            for (int b = 0; b < 2; ++b)
#pragma unroll
                for (int m = 0; m < 4; ++m)
#pragma unroll
                    for (int n = 0; n < 2; ++n) acc[a][b][m][n] = (f32x4){0.f, 0.f, 0.f, 0.f};
        cur = nxt; cB = nB; ++ui;
        if constexpr (Sched::GATHER) { off[0][0] = noff[0][0]; off[0][1] = noff[0][1]; off[1][0] = noff[1][0]; off[1][1] = noff[1][1]; } else cA = nA;
        if (wr == 1) G_BAR;
    }
    G_WAIT_V(0);
    G_BAR;
#undef G_SA
#undef G_SB
#undef G_STAGE
#undef G_STAGE_A
#undef G_LDA
#undef G_LDB
#undef G_MMA
#undef G_WAIT_V
#undef G_WAIT_L
#undef G_BAR
#undef G_SCHED
}

typedef f32x4 Acc[2][2][4][2];
__device__ __forceinline__ v4u pack8(const f32x4 a, const f32x4 b) { v4u w; w.x = pk2(a[0], a[1]); w.y = pk2(a[2], a[3]); w.z = pk2(b[0], b[1]); w.w = pk2(b[2], b[3]); return w; }

struct EpiPlain {
    bf16* O; int ldc;
    __device__ __forceinline__ void operator()(const Acc& acc, const Unit& u, int wr, int wc, int fr, int fq) const {
        const int row0 = u.pm * BM + wr * 64 + fr, col0 = u.pn * BM + wc * 32 + 8 * fq;
#pragma unroll
        for (int ai = 0; ai < 2; ++ai)
#pragma unroll
            for (int m = 0; m < 4; ++m) { bf16* rowp = O + (size_t)(row0 + ai * HALF + m * 16) * ldc + col0;
#pragma unroll
                for (int bj = 0; bj < 2; ++bj) *(v4u*)(rowp + bj * HALF) = pack8(acc[ai][bj][m][0], acc[ai][bj][m][1]); }
    }
};
struct EpiIn {
    bf16* CQKV; bf16* Y; float* KPE;
    __device__ __forceinline__ void operator()(const Acc& acc, const Unit& u, int wr, int wc, int fr, int fq) const {
        const int row0 = u.pm * BM + wr * 64 + fr;
        if (u.pn < 2) {
#pragma unroll
            for (int ai = 0; ai < 2; ++ai)
#pragma unroll
                for (int m = 0; m < 4; ++m) { bf16* rowp = CQKV + (size_t)(row0 + ai * HALF + m * 16) * 512 + u.pn * BM + wc * 32 + 8 * fq;
#pragma unroll
                    for (int bj = 0; bj < 2; ++bj) *(v4u*)(rowp + bj * HALF) = pack8(acc[ai][bj][m][0], acc[ai][bj][m][1]); }
        } else if (u.pn < 6) {
            const int cb = (u.pn - 2) * 128 + wc * 32 + 8 * fq;
#pragma unroll
            for (int ai = 0; ai < 2; ++ai)
#pragma unroll
                for (int m = 0; m < 4; ++m) {
                    f32x4 y0, y1;
#pragma unroll
                    for (int i = 0; i < 4; ++i) { y0[i] = acc[ai][0][m][0][i] * sigmoidf_(acc[ai][1][m][0][i]); y1[i] = acc[ai][0][m][1][i] * sigmoidf_(acc[ai][1][m][1][i]); }
                    *(v4u*)(Y + (size_t)(row0 + ai * HALF + m * 16) * 512 + cb) = pack8(y0, y1); }
        } else {
            if (wc == 0) {
#pragma unroll
                for (int ai = 0; ai < 2; ++ai)
#pragma unroll
                    for (int m = 0; m < 4; ++m) { float* p = KPE + (size_t)(row0 + ai * HALF + m * 16) * 32 + 8 * fq; *(f32x4*)p = acc[ai][0][m][0]; *(f32x4*)(p + 4) = acc[ai][0][m][1]; }
            }
        }
    }
};
struct EpiKV {
    bf16* KF; bf16* VF; const float* rskv; const float* kss; const float* kr; const float* gk;
    __device__ __forceinline__ void operator()(const Acc& acc, const Unit& u, int wr, int wc, int fr, int fq) const {
        const int row0 = u.pm * BM + wr * 64 + fr; const int head = 2 * u.pn + (wc & 1);
        if (wc < 2) {
#pragma unroll
            for (int ai = 0; ai < 2; ++ai)
#pragma unroll
                for (int m = 0; m < 4; ++m) { const int row = row0 + ai * HALF + m * 16; const float rs = rskv[row];
                    float ss = 0.f;
#pragma unroll
                    for (int bj = 0; bj < 2; ++bj)
#pragma unroll
                        for (int n = 0; n < 2; ++n) { const f32x4 q = acc[ai][bj][m][n]; ss += (q[0] * q[0] + q[1] * q[1]) + (q[2] * q[2] + q[3] * q[3]); }
                    ss += __shfl_xor(ss, 16); ss += __shfl_xor(ss, 32);
                    const float rn = __builtin_amdgcn_rsqf((ss * rs * rs + kss[row]) * (1.f / 96.f) + EPS); const float sc = rs * rn;
                    bf16* kp = KF + (size_t)row * 768 + head * 96;
#pragma unroll
                    for (int bj = 0; bj < 2; ++bj) { const f32x4 g0 = *(const f32x4*)(gk + 32 * bj + 8 * fq), g1 = *(const f32x4*)(gk + 32 * bj + 8 * fq + 4);
                        *(v4u*)(kp + 32 * bj + 8 * fq) = pack8(acc[ai][bj][m][0] * g0 * sc, acc[ai][bj][m][1] * g1 * sc); }
                    const f32x4 r0 = *(const f32x4*)(kr + (size_t)row * 32 + 8 * fq), r1 = *(const f32x4*)(kr + (size_t)row * 32 + 8 * fq + 4);
                    *(v4u*)(kp + 64 + 8 * fq) = pack8(r0 * rn, r1 * rn); asm volatile("" ::: "memory"); }
        } else {
#pragma unroll
            for (int ai = 0; ai < 2; ++ai)
#pragma unroll
                for (int m = 0; m < 4; ++m) { const int row = row0 + ai * HALF + m * 16; const float rs = rskv[row]; bf16* vp = VF + (size_t)row * 512 + head * 64 + 8 * fq;
#pragma unroll
                    for (int bj = 0; bj < 2; ++bj) *(v4u*)(vp + 32 * bj) = pack8(acc[ai][bj][m][0] * rs, acc[ai][bj][m][1] * rs); asm volatile("" ::: "memory"); }
        }
    }
};
struct EpiX1 {
    const float* X; float* OUT; bf16* X1B;
    __device__ __forceinline__ void operator()(const Acc& acc, const Unit& u, int wr, int wc, int fr, int fq) const {
        const int row0 = u.pm * BM + wr * 64 + fr, col0 = u.pn * BM + wc * 32 + 8 * fq;
#pragma unroll
        for (int ai = 0; ai < 2; ++ai)
#pragma unroll
            for (int m = 0; m < 4; ++m) { const size_t o = (size_t)(row0 + ai * HALF + m * 16) * D + col0;
#pragma unroll
                for (int bj = 0; bj < 2; ++bj) { const f32x4 a = acc[ai][bj][m][0] + *(const f32x4*)(X + o + bj * HALF), b = acc[ai][bj][m][1] + *(const f32x4*)(X + o + bj * HALF + 4);
                    *(f32x4*)(OUT + o + bj * HALF) = a; *(f32x4*)(OUT + o + bj * HALF + 4) = b; *(v4u*)(X1B + o + bj * HALF) = pack8(a, b); } asm volatile("" ::: "memory"); }
    }
};
struct EpiGU {
    bf16* ACT; const float* bgu; const float* rsl; const LAS int* EC;
    __device__ __forceinline__ void operator()(const Acc& acc, const Unit& u, int wr, int wc, int fr, int fq) const {
        const int r0 = wr * 64 + fr; const int cb = u.pn * 128 + wc * 32 + 8 * fq; const int cnt = EC[u.e];
        const float* bg = bgu + (size_t)u.e * 2048 + cb;
        const f32x4 bg0 = *(const f32x4*)bg, bg1 = *(const f32x4*)(bg + 4), bu0 = *(const f32x4*)(bg + 1024), bu1 = *(const f32x4*)(bg + 1028);
#pragma unroll
        for (int ai = 0; ai < 2; ++ai)
#pragma unroll
            for (int m = 0; m < 4; ++m) { const int rr = r0 + ai * HALF + m * 16; const int sl = u.rt * BM + rr;
                const float rs = (sl < cnt) ? rsl[(size_t)u.e * T + sl] : 0.f;
                f32x4 o[2];
#pragma unroll
                for (int n = 0; n < 2; ++n) { const f32x4 gb = n ? bg1 : bg0, ub = n ? bu1 : bu0;
#pragma unroll
                    for (int i = 0; i < 4; ++i) { float gt = fminf(acc[ai][0][m][n][i] * rs + gb[i], 7.f); float up = fminf(fmaxf(acc[ai][1][m][n][i] * rs + ub[i], -7.f), 7.f);
                        o[n][i] = (up + 1.f) * gt * sigmoidf_(1.702f * gt); } }
                *(v4u*)(ACT + (size_t)(u.pm * BM + rr) * 1024 + cb) = pack8(o[0], o[1]); asm volatile("" ::: "memory"); }
    }
};
struct EpiDown {
    bf16* YS; const float* bd;
    __device__ __forceinline__ void operator()(const Acc& acc, const Unit& u, int wr, int wc, int fr, int fq) const {
        const int row0 = u.pm * BM + wr * 64 + fr, col0 = u.pn * BM + wc * 32 + 8 * fq;
        f32x4 b[2][2];
#pragma unroll
        for (int bj = 0; bj < 2; ++bj) { b[bj][0] = *(const f32x4*)(bd + (size_t)u.e * 1024 + col0 + bj * HALF); b[bj][1] = *(const f32x4*)(bd + (size_t)u.e * 1024 + col0 + bj * HALF + 4); }
#pragma unroll
        for (int ai = 0; ai < 2; ++ai)
#pragma unroll
            for (int m = 0; m < 4; ++m) { bf16* rowp = YS + (size_t)(row0 + ai * HALF + m * 16) * 1024 + col0;
#pragma unroll
                for (int bj = 0; bj < 2; ++bj) *(v4u*)(rowp + bj * HALF) = pack8(acc[ai][bj][m][0] + b[bj][0], acc[ai][bj][m][1] + b[bj][1]); }
    }
};
}

struct Args {
    const float* x; const int* positions; const float* norm_mix_g; const float* w_in; const float* q_latent_g; const float* w_uq; const float* kv_latent_g; const float* w_ukv;
    const float* q_head_g; const float* k_head_g; const float* conv_dw_w; const float* conv_dw_b; const float* conv_ln_g; const float* conv_ln_b; const float* attn_out_g; const float* conv_out_g;
    const float* w_out; const float* norm_ffn_g; const float* router_w; const float* router_b; const float* w_gate_up; const float* b_gate_up; const float* w_down; const float* b_down;
    float* out; unsigned char* ws; int ph_lo, ph_hi;
};

__device__ __forceinline__ void tr_item(const float* __restrict__ W, int ldw, int n0s, const float* __restrict__ gain, bf16* WT, int K, int n0d, int k0, LAS float* scr, int lane) {
    const int c = lane & 7;
    if (n0s < 0) {
#pragma unroll
        for (int j = 0; j < 4; ++j) { const int n = (lane >> 3) + 8 * j; *(GAS v4u*)(WT + (size_t)(n0d + n) * K + k0 + 8 * c) = (v4u){0u, 0u, 0u, 0u}; }
        return;
    }
    float v[32];
#pragma unroll
    for (int i = 0; i < 32; ++i) { const int kk = 2 * i + (lane >> 5); v[i] = W[(size_t)(k0 + kk) * ldw + n0s + (lane & 31)]; }
    if (gain) {
#pragma unroll
        for (int i = 0; i < 32; ++i) v[i] *= gain[k0 + 2 * i + (lane >> 5)];
    }
#pragma unroll
    for (int i = 0; i < 32; ++i) { const int kk = 2 * i + (lane >> 5); scr[kk * 33 + (lane & 31)] = v[i]; }
    LDS_WAIT(); asm volatile("" ::: "memory");
#pragma unroll
    for (int j = 0; j < 4; ++j) { const int n = (lane >> 3) + 8 * j; const LAS float* s = scr + (8 * c) * 33 + n;
        v4u o; o.x = pk2(s[0 * 33], s[1 * 33]); o.y = pk2(s[2 * 33], s[3 * 33]); o.z = pk2(s[4 * 33], s[5 * 33]); o.w = pk2(s[6 * 33], s[7 * 33]);
        *(GAS v4u*)(WT + (size_t)(n0d + n) * K + k0 + 8 * c) = o; }
    LDS_WAIT(); asm volatile("" ::: "memory");
}

__device__ __forceinline__ void p0_prologue(const Args& a, LAS unsigned char* lds, int vcu, int G, int wave, int lane, int tid) {
    unsigned char* ws = a.ws;
    LAS float* scr = (LAS float*)(lds + wave * 16384);
    const int gw = vcu * 8 + wave, NGW = G * 8;
    constexpr int I_IN = 16 * 56, I_UQ = 6 * 24, I_UKV = 2 * 32, I_OUT = 16 * 32, I_GU = 32 * 1024, I_D = 32 * 512;
    constexpr int NITEMS = I_IN + I_UQ + I_UKV + I_OUT + I_GU + I_D;
    for (int it = gw; it < NITEMS; it += NGW) {
        int r = it;
        if (r < I_GU) {
            const int e = r >> 10, r2 = r & 1023, nb = r2 & 63, kb = r2 >> 6, tn = nb >> 3, w = nb & 7;
            const int src = (w < 4) ? (128 * tn + 32 * w) : (1024 + 128 * tn + 32 * (w - 4));
            tr_item(a.w_gate_up + (size_t)e * 1024 * 2048, 2048, src, a.norm_ffn_g, (bf16*)(ws + WS_WGU) + (size_t)e * 2048 * 1024, 1024, 32 * nb, 64 * kb, scr, lane); continue; }
        r -= I_GU;
        if (r < I_D) { const int e = r >> 9, r2 = r & 511, nb = r2 & 31, kb = r2 >> 5;
            tr_item(a.w_down + (size_t)e * 1024 * 1024, 1024, 32 * nb, nullptr, (bf16*)(ws + WS_WD) + (size_t)e * 1024 * 1024, 1024, 32 * nb, 64 * kb, scr, lane); continue; }
        r -= I_D;
        if (r < I_IN) { const int nb = r % 56, kb = r / 56; int src;
            if (nb < 16) src = 32 * nb; else if (nb < 48) { const int tn = (nb - 16) >> 3, w = (nb - 16) & 7; src = (w < 4) ? (544 + 128 * tn + 32 * w) : (544 + 512 + 128 * tn + 32 * (w - 4)); } else if (nb == 48) src = 512; else src = -1;
            tr_item(a.w_in, INW, src, nullptr, (bf16*)(ws + WS_WIN), 1024, 32 * nb, 64 * kb, scr, lane); continue; }
        r -= I_IN;
        if (r < I_UQ) { const int nb = r % 24, kb = r / 24; tr_item(a.w_uq, 768, 32 * nb, a.q_latent_g, (bf16*)(ws + WS_WUQ), QL, 32 * nb, 64 * kb, scr, lane); continue; }
        r -= I_UQ;
        if (r < I_UKV) { const int nb = r % 32, kb = r / 32, tn = nb >> 3, w = nb & 7, bj = w >> 2, wc = w & 3; const int head = 2 * tn + (wc & 1), isv = wc >> 1;
            tr_item(a.w_ukv, 1024, head * 128 + isv * 64 + 32 * bj, a.kv_latent_g, (bf16*)(ws + WS_WUKV), KVL, 32 * nb, 64 * kb, scr, lane); continue; }
        r -= I_UKV;
        { const int nb = r % 32, kb = r / 32; tr_item(a.w_out, 1024, 32 * nb, nullptr, (bf16*)(ws + WS_WOUT), 1024, 32 * nb, 64 * kb, scr, lane); }
    }
    {
        f32x4 g[4];
#pragma unroll
        for (int j = 0; j < 4; ++j) g[j] = ((const f32x4*)a.norm_mix_g)[lane + 64 * j];
        bf16* H1 = (bf16*)(ws + WS_H1);
        for (int m = gw; m < T; m += NGW) {
            const GAS f32x4* xr = (const GAS f32x4*)(a.x + (size_t)m * D) + lane;
            f32x4 v[4]; float s = 0.f;
#pragma unroll
            for (int j = 0; j < 4; ++j) { v[j] = xr[64 * j]; s += (v[j].x * v[j].x + v[j].y * v[j].y) + (v[j].z * v[j].z + v[j].w * v[j].w); }
            const float rstd = __builtin_amdgcn_rsqf(wave_sum(s) * (1.f / D) + EPS);
            GAS v2u* o8 = (GAS v2u*)(H1 + (size_t)m * D) + lane;
#pragma unroll
            for (int j = 0; j < 4; ++j) { v2u w; w.x = pk2(v[j].x * rstd * g[j].x, v[j].y * rstd * g[j].y); w.y = pk2(v[j].z * rstd * g[j].z, v[j].w * rstd * g[j].w); o8[64 * j] = w; }
        }
    }
    {
        const int gt = vcu * 512 + tid, NT_ = G * 512;
        f32x2* cs = (f32x2*)(ws + WS_CS);
        for (int idx = gt; idx < T * 16; idx += NT_) {
            const int t = idx >> 4, i = idx & 15;
            const float p4[4] = {1.0f, 1.7782794100389228f, 3.1622776601683795f, 5.623413251903491f};
            float pw = p4[i & 3]; const int dec = i >> 2; pw *= (dec == 0 ? 1.f : dec == 1 ? 10.f : dec == 2 ? 100.f : 1000.f);
            const float inv = 1.0f / pw;
            const float ang = (float)a.positions[t] * inv;
            const double rev = (double)ang * 0.15915494309189535; const double fr = rev - __builtin_rint(rev);
            float sn, cn; sincospif((float)(2.0 * fr), &sn, &cn);
            cs[idx] = (f32x2){cn, sn};
        }
        bf16* RT = (bf16*)(ws + WS_RT);
        for (int idx = gt; idx < 1024 * 32; idx += NT_) {
            const int k = idx >> 5, e = idx & 31; const float v = a.norm_ffn_g[k] * a.router_w[idx];
            const unsigned hi = pk2(v, 0.f) & 0xffffu; const float lo = v - bflo(hi);
            const int s = k >> 5, kq = (k >> 3) & 3, j = k & 7; const int di = ((s * 4 + kq) * 32 + e) * 8 + j;
            RT[di] = (bf16)hi; RT[32768 + di] = (bf16)(pk2(lo, 0.f) & 0xffffu);
        }
    }
}

__device__ __forceinline__ void p2_thin(const Args& a, LAS unsigned char* lds, int vcu, int G, int wave, int lane, int tid) {
    unsigned char* ws = a.ws;
    LAS float* wl = (LAS float*)lds;
    for (int i = tid; i < 32 * 512 / 4; i += 512) ((LAS f32x4*)wl)[i] = (i < CK * 512 / 4) ? ((const f32x4*)a.conv_dw_w)[i] : (f32x4){0.f, 0.f, 0.f, 0.f};
    __syncthreads();
    const bf16* CQKV = (const bf16*)(ws + WS_CQKV); const bf16* Y = (const bf16*)(ws + WS_Y); const float* KPE = (const float*)(ws + WS_KPE);
    float* RSQ = (float*)(ws + WS_RSQ); float* RSKV = (float*)(ws + WS_RSKV); float* KSS = (float*)(ws + WS_KSS); float* KR = (float*)(ws + WS_KR);
    const f32x2* CS = (const f32x2*)(ws + WS_CS); bf16* MIX = (bf16*)(ws + WS_MIX);
    const int c0 = 8 * lane;
    float dwb[8], lng[8], lnb[8], cog[8];
#pragma unroll
    for (int i = 0; i < 8; ++i) { dwb[i] = a.conv_dw_b[c0 + i]; lng[i] = a.conv_ln_g[c0 + i]; lnb[i] = a.conv_ln_b[c0 + i]; cog[i] = a.conv_out_g[c0 + i]; }
    const float gk1 = a.k_head_g[64 + (lane & 15)], gk2 = a.k_head_g[80 + (lane & 15)];
    const int gw = vcu * 8 + wave, NGW = G * 8;
    for (int blk = gw; blk < T / 4; blk += NGW) {
        const int t0 = blk * 4, tb = t0 & (S - 1);
#pragma unroll
        for (int r = 0; r < 4; ++r) { const int row = t0 + r;
            const v4u w = *(const v4u*)(CQKV + (size_t)row * 512 + c0);
            float ss = 0.f;
#pragma unroll
            for (int i = 0; i < 4; ++i) { const float lo = bflo(w[i]), hi = bfhi(w[i]); ss += lo * lo + hi * hi; }
            const float sq = wave_sum(lane < 48 ? ss : 0.f), skv = wave_sum(lane >= 48 ? ss : 0.f);
            const float kv = (lane < 32) ? KPE[(size_t)row * 32 + lane] : 0.f;
            const float ks = wave_sum(kv * kv);
            const float x1 = gk1 * __shfl(kv, lane & 15), x2 = gk2 * __shfl(kv, 16 + (lane & 15));
            const f32x2 cs = CS[(size_t)row * 16 + (lane & 15)];
            if (lane < 16) KR[(size_t)row * 32 + lane] = x1 * cs.x - x2 * cs.y;
            else if (lane < 32) KR[(size_t)row * 32 + lane] = x2 * cs.x + x1 * cs.y;
            if (lane == 0) { RSQ[row] = __builtin_amdgcn_rsqf(sq * (1.f / QL) + EPS); RSKV[row] = __builtin_amdgcn_rsqf(skv * (1.f / KVL) + EPS); KSS[row] = ks; }
        }
        float acc[4][8];
#pragma unroll
        for (int r = 0; r < 4; ++r)
#pragma unroll
            for (int i = 0; i < 8; ++i) acc[r][i] = dwb[i];
        float win[4][8];
#define LOADROW(dst, q) do { v4u w_ = (v4u){0u, 0u, 0u, 0u}; if (tb + (q) >= 0) w_ = *(const v4u*)(Y + (size_t)(t0 + (q)) * 512 + c0); \
            _Pragma("unroll") for (int i_ = 0; i_ < 4; ++i_) { dst[2 * i_] = bflo(w_[i_]); dst[2 * i_ + 1] = bfhi(w_[i_]); } } while (0)
        LOADROW(win[0], -30); LOADROW(win[1], -29); LOADROW(win[2], -28);
#pragma unroll 1
        for (int jb = 0; jb < 32; jb += 4) {
#pragma unroll
            for (int jj = 0; jj < 4; ++jj) { const int j = jb + jj;
                if (j - 27 < 4) LOADROW(win[(jj + 3) & 3], j - 27);
                const f32x4 w0 = *(const LAS f32x4*)(wl + j * 512 + c0), w1 = *(const LAS f32x4*)(wl + j * 512 + c0 + 4);
#pragma unroll
                for (int r = 0; r < 4; ++r)
#pragma unroll
                    for (int i = 0; i < 8; ++i) acc[r][i] += (i < 4 ? w0[i] : w1[i - 4]) * win[(jj + r) & 3][i];
            }
            asm volatile("" ::: "memory");
        }
#undef LOADROW
#pragma unroll
        for (int r = 0; r < 4; ++r) {
            float s1 = 0.f;
#pragma unroll
            for (int i = 0; i < 8; ++i) s1 += acc[r][i];
            const float mean = wave_sum(s1) * (1.f / CW);
            float s2 = 0.f;
#pragma unroll
            for (int i = 0; i < 8; ++i) { acc[r][i] -= mean; s2 += acc[r][i] * acc[r][i]; }
            const float rstd = __builtin_amdgcn_rsqf(wave_sum(s2) * (1.f / CW) + EPS);
            float s3 = 0.f;
#pragma unroll
            for (int i = 0; i < 8; ++i) { const float z = acc[r][i] * rstd * lng[i] + lnb[i]; const float sg = z * sigmoidf_(z); acc[r][i] = sg; s3 += sg * sg; }
            const float r3 = __builtin_amdgcn_rsqf(wave_sum(s3) * (1.f / CW) + EPS);
            v4u o;
#pragma unroll
            for (int i = 0; i < 4; ++i) o[i] = pk2(acc[r][2 * i] * r3 * cog[2 * i], acc[r][2 * i + 1] * r3 * cog[2 * i + 1]);
            *(v4u*)(MIX + (size_t)(t0 + r) * 1024 + 512 + c0) = o;
        }
    }
}

namespace at {
constexpr int KSLOT = 12288, VSLOT = 8192, NSLOT = 3;
constexpr int L_K = 0, L_V = NSLOT * KSLOT, L_WS = L_V + NSLOT * VSLOT, L_OST = L_WS + 8 * 64 * 4, L_END = L_OST + 8 * 4096;
static_assert(L_END <= RING_BYTES, "attention LDS");
__device__ __forceinline__ int crow(int r, int hi) { return (r & 3) + 8 * (r >> 2) + 4 * hi; }
__device__ __forceinline__ void glds16(const void* gsrc, unsigned lds_dst) { unsigned keep;
    asm volatile("s_mov_b32 %0, m0\n\ts_mov_b32 m0, %2\n\ts_nop 0\n\tglobal_load_lds_dwordx4 %1, off\n\ts_mov_b32 m0, %0" : "=&s"(keep) : "v"(gsrc), "s"(lds_dst) : "memory"); }
typedef short v4i16_t __attribute__((ext_vector_type(4)));
__device__ __forceinline__ s16x4 vtr(const LAS char* p) { return __builtin_bit_cast(s16x4, __builtin_amdgcn_ds_read_tr16_b64_v4i16((LAS v4i16_t*)p)); }

__device__ __forceinline__ void attn_unit(const Args& a, int b, int h, int qb, LAS unsigned char* shm3) {
    unsigned char* ws = a.ws;
    const bf16* QRAW = (const bf16*)(ws + WS_QRAW); const bf16* KF = (const bf16*)(ws + WS_KF); const bf16* VF = (const bf16*)(ws + WS_VF); bf16* AO = (bf16*)(ws + WS_AO);
    const float* RSQ = (const float*)(ws + WS_RSQ); const f32x2* CS = (const f32x2*)(ws + WS_CS);
    const int tid = threadIdx.x, lane = tid & 63, r32 = lane & 31, hi = lane >> 5; const int wid = __builtin_amdgcn_readfirstlane(tid >> 6);
    const long rowbase = (long)b * S; const int q0 = qb * 256;
    const int NT = 4 * qb + 4, my_nt = 4 * qb + (wid >> 1) + 1;
    const long myrow = rowbase + q0 + wid * 32 + r32;
    const unsigned lds0 = (unsigned)(uintptr_t)shm3;
    bf16x8 qr[6]; f32x16 negm;
    {
        const bf16* qp = QRAW + myrow * 768 + h * 96 + 8 * hi;
        float f[6][8]; float ss = 0.f;
#pragma unroll
        for (int d0 = 0; d0 < 6; ++d0) { const v4u w = *(const v4u*)(qp + 16 * d0);
#pragma unroll
            for (int i = 0; i < 4; ++i) { f[d0][2 * i] = bflo(w[i]); f[d0][2 * i + 1] = bfhi(w[i]); ss += f[d0][2 * i] * f[d0][2 * i] + f[d0][2 * i + 1] * f[d0][2 * i + 1]; } }
        ss = swap_sum(ss);
        const float rq = RSQ[myrow];
        const float rn = rq * __builtin_amdgcn_rsqf(rq * rq * ss * (1.f / 96.f) + EPS);
#pragma unroll
        for (int d0 = 0; d0 < 6; ++d0) { const f32x4 g0 = *(const f32x4*)(a.q_head_g + 16 * d0 + 8 * hi), g1 = *(const f32x4*)(a.q_head_g + 16 * d0 + 8 * hi + 4);
#pragma unroll
            for (int i = 0; i < 4; ++i) { f[d0][i] *= rn * g0[i]; f[d0][4 + i] *= rn * g1[i]; } }
        const f32x2* csr = CS + myrow * 16 + 8 * hi;
#pragma unroll
        for (int j = 0; j < 8; ++j) { const f32x2 cs = csr[j]; const float x1 = f[4][j], x2 = f[5][j]; f[4][j] = x1 * cs.x - x2 * cs.y; f[5][j] = x2 * cs.x + x1 * cs.y; }
        float n2 = 0.f;
#pragma unroll
        for (int d0 = 0; d0 < 6; ++d0)
#pragma unroll
            for (int j = 0; j < 8; ++j) n2 += f[d0][j] * f[d0][j];
        n2 = swap_sum(n2);
        float gm_ = fabsf(a.k_head_g[lane]); if (lane < 32) gm_ = fmaxf(gm_, fabsf(a.k_head_g[64 + lane])); gm_ = wave_max(gm_);
        const float Mq = __builtin_sqrtf(n2) * gm_ * (9.797959f * 1.02f) * C2;
#pragma unroll
        for (int d0 = 0; d0 < 6; ++d0) { v4u w;
#pragma unroll
            for (int i = 0; i < 4; ++i) w[i] = pk2(f[d0][2 * i] * C2, f[d0][2 * i + 1] * C2);
            qr[d0] = __builtin_bit_cast(bf16x8, w); }
#pragma unroll
        for (int r = 0; r < 16; ++r) negm[r] = -Mq;
    }
    VM_WAIT();
    __builtin_amdgcn_sched_barrier(0);
    const bf16* ksrc = KF + (rowbase + lane) * 768 + h * 96 + 8 * wid;
    const bf16* vsrc = VF + (rowbase + 16 * (wid & 3) + (lane >> 2)) * 512 + h * 64 + (wid >> 2) * 32 + (lane & 3) * 8;
    const unsigned kdst = lds0 + L_K + wid * 1024, vdst = lds0 + L_V + wid * 1024;
#define DMA_TILE(t, sl) do { const bf16* ks_ = ksrc + (long)(t) * 64 * 768; \
        glds16(ks_, (unsigned)__builtin_amdgcn_readfirstlane(kdst + (sl) * KSLOT)); \
        if (wid < 4) glds16(ks_ + 64, (unsigned)__builtin_amdgcn_readfirstlane(kdst + (sl) * KSLOT + 8192)); \
        glds16(vsrc + (long)(t) * 64 * 512, (unsigned)__builtin_amdgcn_readfirstlane(vdst + (sl) * VSLOT)); } while (0)
    DMA_TILE(0, 0); DMA_TILE(1, 1);
    float lsum = 0.f; f32x16 o0 = {}, o1 = {};
    const LAS char* kp0 = (const LAS char*)shm3 + L_K + hi * 1024 + r32 * 16;
    const LAS char* vp0 = (const LAS char*)shm3 + L_V + ((lane >> 4) & 1) * 32 + (lane & 3) * 8 + (4 * hi + ((lane & 15) >> 2)) * 64;
    int slot = 0;
    for (int j = 0; j < NT; ++j) {
        if (j + 1 < NT) { if (wid < 4) asm volatile("s_waitcnt vmcnt(3)" ::: "memory"); else asm volatile("s_waitcnt vmcnt(2)" ::: "memory"); }
        else asm volatile("s_waitcnt vmcnt(0)" ::: "memory");
        asm volatile("s_waitcnt lgkmcnt(0)\n\ts_barrier" ::: "memory");
        if (j + 2 < NT) { const int s2 = (slot >= 1) ? slot - 1 : 2; DMA_TILE(j + 2, s2); }
        if (j < my_nt) {
            const LAS char* kp = kp0 + slot * KSLOT;
            f32x16 p0 = negm, p1 = negm;
#pragma unroll
            for (int d0 = 0; d0 < 6; ++d0) {
                const bf16x8 k0 = *(const LAS bf16x8*)(kp + d0 * 2048), k1 = *(const LAS bf16x8*)(kp + d0 * 2048 + 512);
                p0 = __builtin_amdgcn_mfma_f32_32x32x16_bf16(k0, qr[d0], p0, 0, 0, 0);
                p1 = __builtin_amdgcn_mfma_f32_32x32x16_bf16(k1, qr[d0], p1, 0, 0, 0);
            }
            float sacc = 0.f;
#pragma unroll
            for (int r = 0; r < 16; ++r) { p0[r] = fast_exp2(p0[r]); p1[r] = fast_exp2(p1[r]); sacc += p0[r] + p1[r]; }
            lsum += sacc;
            v4u pw[4];
#pragma unroll
            for (int i = 0; i < 4; ++i) { pw[0][i] = pk2(p0[2 * i], p0[2 * i + 1]); pw[1][i] = pk2(p0[8 + 2 * i], p0[9 + 2 * i]); pw[2][i] = pk2(p1[2 * i], p1[2 * i + 1]); pw[3][i] = pk2(p1[8 + 2 * i], p1[9 + 2 * i]); }
            const LAS char* vp = vp0 + slot * VSLOT;
#pragma unroll
            for (int ks = 0; ks < 4; ++ks) {
                const s16x4 l0 = vtr(vp + ks * 1024), h0 = vtr(vp + ks * 1024 + 512), l1 = vtr(vp + 4096 + ks * 1024), h1 = vtr(vp + 4096 + ks * 1024 + 512);
                const bf16x8 v0 = (bf16x8){l0[0], l0[1], l0[2], l0[3], h0[0], h0[1], h0[2], h0[3]}, v1 = (bf16x8){l1[0], l1[1], l1[2], l1[3], h1[0], h1[1], h1[2], h1[3]};
                const bf16x8 pa = __builtin_bit_cast(bf16x8, pw[ks]);
                o0 = __builtin_amdgcn_mfma_f32_32x32x16_bf16(pa, v0, o0, 0, 0, 0);
                o1 = __builtin_amdgcn_mfma_f32_32x32x16_bf16(pa, v1, o1, 0, 0, 0);
            }
        }
        slot = (slot == 2) ? 0 : slot + 1;
    }
#undef DMA_TILE
    lsum = swap_sum(lsum);
    LAS float* wsf = (LAS float*)(shm3 + L_WS) + wid * 64;
    if (hi == 0) wsf[r32] = lsum;
    LDS_WAIT();
    LAS bf16* stg = (LAS bf16*)(shm3 + L_OST) + wid * 2048;
#pragma unroll
    for (int r = 0; r < 16; ++r) { const int orow = crow(r, hi); const float rl = __builtin_amdgcn_rcpf(wsf[orow]);
        stg[orow * 64 + r32] = (bf16)(pk2(o0[r] * rl, 0.f) & 0xffffu); stg[orow * 64 + 32 + r32] = (bf16)(pk2(o1[r] * rl, 0.f) & 0xffffu); }
    LDS_WAIT();
    bf16* Ow = AO + (rowbase + q0 + wid * 32) * 512 + h * 64;
#pragma unroll
    for (int i = 0; i < 4; ++i) { const int row = i * 8 + (lane >> 3), ch = lane & 7; const v4u v = *(const LAS v4u*)(stg + row * 64 + ch * 8); *(v4u*)(Ow + (long)row * 512 + ch * 8) = v; }
    asm volatile("s_waitcnt lgkmcnt(0)\n\ts_barrier" ::: "memory");
}
}

__device__ __forceinline__ void p5_attn_norm(const Args& a, int vcu, int G, int wave, int lane) {
    const bf16* AO = (const bf16*)(a.ws + WS_AO); bf16* MIX = (bf16*)(a.ws + WS_MIX);
    const int c0 = 8 * lane; float g[8];
#pragma unroll
    for (int i = 0; i < 8; ++i) g[i] = a.attn_out_g[c0 + i];
    const int gw = vcu * 8 + wave, NGW = G * 8;
    for (int row = gw; row < T; row += NGW) {
        const v4u w = *(const v4u*)(AO + (size_t)row * 512 + c0);
        float f[8]; float ss = 0.f;
#pragma unroll
        for (int i = 0; i < 4; ++i) { f[2 * i] = bflo(w[i]); f[2 * i + 1] = bfhi(w[i]); ss += f[2 * i] * f[2 * i] + f[2 * i + 1] * f[2 * i + 1]; }
        const float r = __builtin_amdgcn_rsqf(wave_sum(ss) * (1.f / AW) + EPS);
        v4u o;
#pragma unroll
        for (int i = 0; i < 4; ++i) o[i] = pk2(f[2 * i] * r * g[2 * i], f[2 * i + 1] * r * g[2 * i + 1]);
        *(v4u*)(MIX + (size_t)row * 1024 + c0) = o;
    }
}

__device__ __forceinline__ void p7_router(const Args& a, LAS unsigned char* lds, int vcu, int G, int wave, int lane, int tid) {
    unsigned char* ws = a.ws;
    for (int i = tid; i < 8192; i += 512) ((LAS v4u*)lds)[i] = ((const v4u*)(ws + WS_RT))[i];
    LAS int* LCNT = (LAS int*)(lds + LCNT_OFF); LAS int* LBASE = (LAS int*)(lds + LBASE_OFF);
    gu32* gcnt = (gu32*)(ws + WS_CTL) + CW_CNT;
    int* POS = (int*)(ws + WS_POS); float* GWt = (float*)(ws + WS_GW); int* TOKL = (int*)(ws + WS_TOKL); float* RSL = (float*)(ws + WS_RSL);
    const int fr = lane & 15, kq = lane >> 4;
    for (int rnd = vcu; rnd < T / 128; rnd += G) {
        if (tid < 32) LCNT[tid] = 0;
        __syncthreads();
        const int t = rnd * 128 + wave * 16 + fr;
        const float* xr = a.out + (size_t)t * D + 8 * kq;
        f32x4 d0 = {0.f, 0.f, 0.f, 0.f}, d1 = {0.f, 0.f, 0.f, 0.f}; float ss = 0.f;
        const LAS char* rp = (const LAS char*)lds + (kq * 32 + fr) * 16;
#pragma unroll 4
        for (int s = 0; s < 32; ++s) {
            const f32x4 xa = *(const f32x4*)(xr + 32 * s), xb = *(const f32x4*)(xr + 32 * s + 4);
            ss += (xa[0] * xa[0] + xa[1] * xa[1]) + (xa[2] * xa[2] + xa[3] * xa[3]) + (xb[0] * xb[0] + xb[1] * xb[1]) + (xb[2] * xb[2] + xb[3] * xb[3]);
            v4u hw, lw;
            hw[0] = pk2(xa[0], xa[1]); hw[1] = pk2(xa[2], xa[3]); hw[2] = pk2(xb[0], xb[1]); hw[3] = pk2(xb[2], xb[3]);
            lw[0] = pk2(xa[0] - bflo(hw[0]), xa[1] - bfhi(hw[0])); lw[1] = pk2(xa[2] - bflo(hw[1]), xa[3] - bfhi(hw[1]));
            lw[2] = pk2(xb[0] - bflo(hw[2]), xb[1] - bfhi(hw[2])); lw[3] = pk2(xb[2] - bflo(hw[3]), xb[3] - bfhi(hw[3]));
            const bf16x8 xh = __builtin_bit_cast(bf16x8, hw), xl = __builtin_bit_cast(bf16x8, lw);
            const bf16x8 rh0 = *(const LAS bf16x8*)(rp + s * 2048), rh1 = *(const LAS bf16x8*)(rp + s * 2048 + 256);
            const bf16x8 rl0 = *(const LAS bf16x8*)(rp + 65536 + s * 2048), rl1 = *(const LAS bf16x8*)(rp + 65536 + s * 2048 + 256);
            d0 = __builtin_amdgcn_mfma_f32_16x16x32_bf16(rh0, xh, d0, 0, 0, 0); d1 = __builtin_amdgcn_mfma_f32_16x16x32_bf16(rh1, xh, d1, 0, 0, 0);
            d0 = __builtin_amdgcn_mfma_f32_16x16x32_bf16(rl0, xh, d0, 0, 0, 0); d1 = __builtin_amdgcn_mfma_f32_16x16x32_bf16(rl1, xh, d1, 0, 0, 0);
            d0 = __builtin_amdgcn_mfma_f32_16x16x32_bf16(rh0, xl, d0, 0, 0, 0); d1 = __builtin_amdgcn_mfma_f32_16x16x32_bf16(rh1, xl, d1, 0, 0, 0);
        }
        ss += __shfl_xor(ss, 16); ss += __shfl_xor(ss, 32);
        const float rstd = __builtin_amdgcn_rsqf(ss * (1.f / D) + EPS);
        float lg[32];
#pragma unroll
        for (int q = 0; q < 4; ++q)
#pragma unroll
            for (int r = 0; r < 4; ++r) { lg[4 * q + r] = __shfl(d0[r], fr + 16 * q) * rstd + a.router_b[4 * q + r]; lg[16 + 4 * q + r] = __shfl(d1[r], fr + 16 * q) * rstd + a.router_b[16 + 4 * q + r]; }
        unsigned taken = 0u; float tv[4]; int ti[4];
#pragma unroll
        for (int k = 0; k < 4; ++k) { float best = -INFINITY; int bi = 0;
#pragma unroll
            for (int e = 0; e < 32; ++e) { const bool ok = !((taken >> e) & 1u) && (lg[e] > best); best = ok ? lg[e] : best; bi = ok ? e : bi; }
            tv[k] = best; ti[k] = bi; taken |= 1u << bi; }
        float ex[4], es = 0.f;
#pragma unroll
        for (int k = 0; k < 4; ++k) { ex[k] = __expf(tv[k] - tv[0]); es += ex[k]; }
        const float ies = 1.f / es;
        int rank[4];
        if (kq == 0) {
#pragma unroll
            for (int k = 0; k < 4; ++k) rank[k] = __hip_atomic_fetch_add(LCNT + ti[k], 1, __ATOMIC_RELAXED, __HIP_MEMORY_SCOPE_WORKGROUP);
        }
        __syncthreads();
        if (tid < 32) { const int c = LCNT[tid]; int base = 0; if (c > 0) base = (int)__hip_atomic_fetch_add(gcnt + 64 * tid, (unsigned)c, __ATOMIC_RELAXED, __HIP_MEMORY_SCOPE_AGENT); LBASE[tid] = base; }
        __syncthreads();
        if (kq == 0) {
#pragma unroll
            for (int k = 0; k < 4; ++k) { const int e = ti[k]; const int sl = LBASE[e] + rank[k];
                TOKL[(size_t)e * T + sl] = t; RSL[(size_t)e * T + sl] = rstd; POS[t * 4 + k] = (e << 16) | sl; GWt[t * 4 + k] = ex[k] * ies; }
        }
        __syncthreads();
    }
}

__device__ __forceinline__ void moe_tables(const Args& a, LAS unsigned char* lds, int tid) {
    LAS int* TS = (LAS int*)(lds + TS_OFF); LAS int* EC = (LAS int*)(lds + ECNT_OFF);
    const gu32* gcnt = (const gu32*)(a.ws + WS_CTL) + CW_CNT;
    if (tid == 0) { int acc = 0; for (int e = 0; e < NE; ++e) { const int c = (int)__hip_atomic_load(gcnt + 64 * e, __ATOMIC_RELAXED, __HIP_MEMORY_SCOPE_AGENT); EC[e] = c; TS[e] = acc; acc += (c + 255) >> 8; } TS[NE] = acc; }
    __syncthreads();
}

__device__ __forceinline__ void p10_combine(const Args& a, LAS unsigned char* lds, int vcu, int G, int wave, int lane) {
    const LAS int* TS = (const LAS int*)(lds + TS_OFF);
    const int* POS = (const int*)(a.ws + WS_POS); const float* GWt = (const float*)(a.ws + WS_GW); const bf16* YS = (const bf16*)(a.ws + WS_YS);
    const int gw = vcu * 8 + wave, NGW = G * 8;
    for (int t = gw; t < T; t += NGW) {
        float* orow = a.out + (size_t)t * D;
        f32x4 v[2][2];
#pragma unroll
        for (int j = 0; j < 2; ++j) { v[j][0] = *(const f32x4*)(orow + 512 * j + 8 * lane); v[j][1] = *(const f32x4*)(orow + 512 * j + 8 * lane + 4); }
#pragma unroll
        for (int k = 0; k < 4; ++k) { const int p = POS[t * 4 + k]; const float w = GWt[t * 4 + k]; const int e = p >> 16, sl = p & 0xffff;
            const bf16* yr = YS + ((size_t)TS[e] * 256 + sl) * 1024;
#pragma unroll
            for (int j = 0; j < 2; ++j) { const v4u y = *(const v4u*)(yr + 512 * j + 8 * lane);
                v[j][0][0] += w * bflo(y[0]); v[j][0][1] += w * bfhi(y[0]); v[j][0][2] += w * bflo(y[1]); v[j][0][3] += w * bfhi(y[1]);
                v[j][1][0] += w * bflo(y[2]); v[j][1][1] += w * bfhi(y[2]); v[j][1][2] += w * bflo(y[3]); v[j][1][3] += w * bfhi(y[3]); } }
#pragma unroll
        for (int j = 0; j < 2; ++j) { *(f32x4*)(orow + 512 * j + 8 * lane) = v[j][0]; *(f32x4*)(orow + 512 * j + 8 * lane + 4) = v[j][1]; }
    }
}

__global__ void __launch_bounds__(512, 2) mk_fwd(Args args) {
    extern __shared__ __attribute__((aligned(16))) unsigned char lds_raw[];
    LAS unsigned char* lds = (LAS unsigned char*)lds_raw;
    const int tid = threadIdx.x, lane = tid & 63, wave = __builtin_amdgcn_readfirstlane(tid >> 6);
    const int G = gridDim.x; const int bx = blockIdx.x; const int vcu = (G % 8 == 0) ? (bx % 8) * (G / 8) + bx / 8 : bx;
    unsigned char* ws = args.ws;
    for (int u = tid; u < (LDS_BYTES - MISC_OFF) / 4; u += 512) ((LAS unsigned*)(lds + MISC_OFF))[u] = 0u;
    __syncthreads();
    gu32* ctl = (gu32*)(ws + WS_CTL);
#if MK_PER_PHASE
#define GRID_BAR() do { } while (0)
#else
    XcdBarrier bar = xcd_barrier_post((unsigned*)ctl + CW_BAR, (volatile LAS unsigned*)(lds + MISC_OFF));
#define GRID_BAR() xcd_barrier(bar)
#endif
    const int lo = args.ph_lo, hi = args.ph_hi;
#define IN(k) (lo <= (k) && (k) < hi)
#define BOTH(k) (IN(k) && IN((k) + 1))

    if (IN(0)) { p0_prologue(args, lds, vcu, G, wave, lane, tid); if (BOTH(0)) GRID_BAR(); }

    if (IN(1)) {
        gm::DenseSched Sd; Sd.init(ws + WS_H1, ws + WS_WIN, T, NIN1, 1024, 1024, G, bx);
        gm::EpiIn E{(bf16*)(ws + WS_CQKV), (bf16*)(ws + WS_Y), (float*)(ws + WS_KPE)};
        gm::gemm_phase(lds, Sd, E);
        if (BOTH(1)) GRID_BAR();
    }
    if (IN(2)) { p2_thin(args, lds, vcu, G, wave, lane, tid); if (BOTH(2)) GRID_BAR(); }

    if (IN(3)) {
        { gm::DenseSched Sd; Sd.init(ws + WS_CQKV, ws + WS_WUQ, T, 768, QL, 512, G, bx);
          gm::EpiPlain E{(bf16*)(ws + WS_QRAW), 768};
          gm::gemm_phase(lds, Sd, E); }
        { gm::DenseSched Sd; Sd.init(ws + WS_CQKV + QL * 2, ws + WS_WUKV, T, 1024, KVL, 512, G, bx);
          gm::EpiKV E{(bf16*)(ws + WS_KF), (bf16*)(ws + WS_VF), (const float*)(ws + WS_RSKV), (const float*)(ws + WS_KSS), (const float*)(ws + WS_KR), args.k_head_g};
          gm::gemm_phase(lds, Sd, E); }
        if (BOTH(3)) GRID_BAR();
    }
    if (IN(4)) {
        for (int v = vcu; v < 256; v += G) {
            const int bh = v >> 2, j = v & 3;
            for (int i = 0; i < 4; ++i) { const int qb = (i == 0) ? j : (i == 1) ? 15 - j : (i == 2) ? 4 + j : 11 - j; at::attn_unit(args, bh >> 3, bh & 7, qb, lds); }
        }
        if (BOTH(4)) GRID_BAR();
    }
    if (IN(5)) { p5_attn_norm(args, vcu, G, wave, lane); if (BOTH(5)) GRID_BAR(); }

    if (IN(6)) {
        gm::DenseSched Sd; Sd.init(ws + WS_MIX, ws + WS_WOUT, T, 1024, 1024, 1024, G, bx);
        gm::EpiX1 E{args.x, args.out, (bf16*)(ws + WS_X1B)};
        gm::gemm_phase(lds, Sd, E);
        if (BOTH(6)) GRID_BAR();
    }
    if (IN(7)) { p7_router(args, lds, vcu, G, wave, lane, tid); if (BOTH(7)) GRID_BAR(); }

    if (IN(8) || IN(9) || IN(10)) moe_tables(args, lds, tid);
    const int ngrp = (G % 8 == 0) ? 8 : 1, cpg = G / ngrp, epg = NE / ngrp;
    if (IN(8)) {
        gm::MoeSched<true> Sm{(const char*)(ws + WS_X1B), (const char*)(ws + WS_WGU), 1024, 1024, 2048, 8, (const int*)(ws + WS_TOKL), (const LAS int*)(lds + TS_OFF), (const LAS int*)(lds + ECNT_OFF), vcu / cpg, vcu % cpg, cpg, epg};
        gm::EpiGU E{(bf16*)(ws + WS_ACT), args.b_gate_up, (const float*)(ws + WS_RSL), (const LAS int*)(lds + ECNT_OFF)};
        gm::gemm_phase(lds, Sm, E);
        if (BOTH(8)) GRID_BAR();
    }
    if (IN(9)) {
        gm::MoeSched<false> Sm{(const char*)(ws + WS_ACT), (const char*)(ws + WS_WD), 1024, 1024, 1024, 4, nullptr, (const LAS int*)(lds + TS_OFF), (const LAS int*)(lds + ECNT_OFF), vcu / cpg, vcu % cpg, cpg, epg};
        gm::EpiDown E{(bf16*)(ws + WS_YS), args.b_down};
        gm::gemm_phase(lds, Sm, E);
        if (BOTH(9)) GRID_BAR();
    }
    if (IN(10)) { p10_combine(args, lds, vcu, G, wave, lane); }
#undef IN
#undef BOTH
}

extern "C" void kernel_launch(void* const* d_in, const int* in_sizes, int n_in, void* d_out, int out_size, void* d_ws, size_t ws_size, hipStream_t stream) {
    static int grid = 0;
    if (grid == 0) {
        if (n_in != 24 || in_sizes[0] != T * D || out_size != T * D || ws_size < WS_END) { fprintf(stderr, "kernel_launch: unexpected shapes (n_in %d, in0 %d, out %d, ws %zu < %zu)\n", n_in, n_in > 0 ? in_sizes[0] : -1, out_size, ws_size, (size_t)WS_END); grid = -1; return; }
        int dev = 0, cus = 0, per_cu = 0;
        if (hipGetDevice(&dev) != hipSuccess || hipDeviceGetAttribute(&cus, hipDeviceAttributeMultiprocessorCount, dev) != hipSuccess) { fprintf(stderr, "kernel_launch: device query failed\n"); grid = -1; return; }
        if (hipFuncSetAttribute((const void*)mk_fwd, hipFuncAttributeMaxDynamicSharedMemorySize, LDS_BYTES) != hipSuccess) { fprintf(stderr, "kernel_launch: hipFuncSetAttribute failed\n"); grid = -1; return; }
        if (hipOccupancyMaxActiveBlocksPerMultiprocessor(&per_cu, (const void*)mk_fwd, 512, LDS_BYTES) != hipSuccess || per_cu < 1) fprintf(stderr, "kernel_launch: occupancy query says %d\n", per_cu);
        (void)hipGetLastError();
        grid = cus;
    }
    if (grid < 0) return;
    if (hipMemsetAsync((char*)d_ws + WS_CTL, 0, CTL_ZERO_BYTES, stream) != hipSuccess) { fprintf(stderr, "kernel_launch: memset failed\n"); return; }
    Args a{};
    a.x = (const float*)d_in[0]; a.positions = (const int*)d_in[1]; a.norm_mix_g = (const float*)d_in[2]; a.w_in = (const float*)d_in[3]; a.q_latent_g = (const float*)d_in[4]; a.w_uq = (const float*)d_in[5];
    a.kv_latent_g = (const float*)d_in[6]; a.w_ukv = (const float*)d_in[7]; a.q_head_g = (const float*)d_in[8]; a.k_head_g = (const float*)d_in[9]; a.conv_dw_w = (const float*)d_in[10]; a.conv_dw_b = (const float*)d_in[11];
    a.conv_ln_g = (const float*)d_in[12]; a.conv_ln_b = (const float*)d_in[13]; a.attn_out_g = (const float*)d_in[14]; a.conv_out_g = (const float*)d_in[15]; a.w_out = (const float*)d_in[16]; a.norm_ffn_g = (const float*)d_in[17];
    a.router_w = (const float*)d_in[18]; a.router_b = (const float*)d_in[19]; a.w_gate_up = (const float*)d_in[20]; a.b_gate_up = (const float*)d_in[21]; a.w_down = (const float*)d_in[22]; a.b_down = (const float*)d_in[23];
    a.out = (float*)d_out; a.ws = (unsigned char*)d_ws;
#if MK_PER_PHASE
    for (int p = 0; p < NPH; ++p) { a.ph_lo = p; a.ph_hi = p + 1; hipLaunchKernelGGL(mk_fwd, dim3(grid), dim3(512), LDS_BYTES, stream, a); }
#else
    a.ph_lo = 0; a.ph_hi = NPH; hipLaunchKernelGGL(mk_fwd, dim3(grid), dim3(512), LDS_BYTES, stream, a);
#endif
    const hipError_t le = hipPeekAtLastError();
    if (le != hipSuccess) fprintf(stderr, "kernel_launch: launch failed: %s\n", hipGetErrorName(le));
}
```

```cpp
#include <hip/hip_runtime.h>
#include <cstdio>
#include <cstdint>

#ifndef MK_PER_PHASE
#define MK_PER_PHASE 0
#endif

#define GAS __attribute__((address_space(1)))
#define LAS __attribute__((address_space(3)))
typedef unsigned short bf16;
typedef unsigned v4u __attribute__((ext_vector_type(4)));
typedef unsigned v2u __attribute__((ext_vector_type(2)));
typedef float f32x4 __attribute__((ext_vector_type(4)));
typedef float f32x2 __attribute__((ext_vector_type(2)));
typedef float f32x16 __attribute__((ext_vector_type(16)));
typedef short bf16x8 __attribute__((ext_vector_type(8)));
typedef short s16x4 __attribute__((ext_vector_type(4)));
typedef int v4i_t __attribute__((ext_vector_type(4)));
typedef int v8i_t __attribute__((ext_vector_type(8)));
typedef __bf16 bf16x2_t __attribute__((ext_vector_type(2)));
typedef GAS unsigned gu32;

constexpr int NB = 8, S = 4096, T = NB * S, D = 1024;
constexpr int NH = 8, DQK = 96, DV = 64;
constexpr int QL = 384, KVL = 128, CW = 512, AW = 512, CK = 31, INW = 1568;
constexpr int NE = 32, DFF = 1024;
constexpr float EPS = 1e-6f;
constexpr int NIN1 = 1792;
constexpr int MAXSLOT = T * 4 + NE * 256;
constexpr float C2 = 0.14724445f;
constexpr int NPH = 11;

constexpr size_t MiB = 1u << 20;
constexpr size_t WS_CTL = 0, CTL_ZERO_BYTES = 1 * MiB;
constexpr size_t WS_WIN = 2 * MiB, WS_WUQ = 6 * MiB, WS_WUKV = 7 * MiB, WS_WOUT = 8 * MiB, WS_RT = 10 * MiB, WS_CS = 12 * MiB;
constexpr size_t WS_RSQ = 16 * MiB, WS_RSKV = WS_RSQ + 128 * 1024, WS_KSS = WS_RSKV + 128 * 1024;
constexpr size_t WS_KR = 17 * MiB, WS_POS = 21 * MiB, WS_GW = WS_POS + 512 * 1024, WS_TOKL = 22 * MiB, WS_RSL = 26 * MiB;
constexpr size_t WS_WGU8 = 32 * MiB, WS_WD8 = 96 * MiB;
constexpr size_t WS_H1 = 128 * MiB, WS_CQKV = 192 * MiB, WS_Y = 224 * MiB, WS_KPE = 256 * MiB;
constexpr size_t WS_QRAW = 260 * MiB, WS_KF = 308 * MiB, WS_VF = 356 * MiB, WS_AO = 388 * MiB, WS_MIX = 420 * MiB, WS_X1Q = 484 * MiB, WS_ACT8 = 516 * MiB;
constexpr size_t WS_YS = 128 * MiB;
constexpr size_t WS_END = 652 * MiB;
static_assert(WS_ACT8 + (size_t)MAXSLOT * 1024 <= WS_END && WS_YS + (size_t)MAXSLOT * 1024 * 2 <= WS_MIX, "ws map");
constexpr int CW_TMO = 0, CW_BAR = 4096, CW_CNT = 32768;

constexpr int RING_BYTES = 131072;
constexpr int MISC_OFF = RING_BYTES;
constexpr int LCNT_OFF = MISC_OFF + 64;
constexpr int LBASE_OFF = LCNT_OFF + 128;
constexpr int TS_OFF = LBASE_OFF + 128;
constexpr int ECNT_OFF = TS_OFF + 160;
constexpr int LDS_BYTES = 147456;

#define LDS_WAIT() asm volatile("s_waitcnt lgkmcnt(0)" ::: "memory")
#define VM_WAIT() asm volatile("s_waitcnt vmcnt(0)" ::: "memory")

__device__ __forceinline__ unsigned pk2(float lo, float hi) { f32x2 v = {lo, hi}; bf16x2_t b = __builtin_convertvector(v, bf16x2_t); return __builtin_bit_cast(unsigned, b); }
__device__ __forceinline__ float clamp448(float v) { return __builtin_fminf(__builtin_fmaxf(v, -448.f), 448.f); }
__device__ __forceinline__ v2u pack8_fp8(float a0, float a1, float a2, float a3, float a4, float a5, float a6, float a7) {
    int w0 = 0, w1 = 0;
    w0 = __builtin_amdgcn_cvt_pk_fp8_f32(clamp448(a0), clamp448(a1), w0, false); w0 = __builtin_amdgcn_cvt_pk_fp8_f32(clamp448(a2), clamp448(a3), w0, true);
    w1 = __builtin_amdgcn_cvt_pk_fp8_f32(clamp448(a4), clamp448(a5), w1, false); w1 = __builtin_amdgcn_cvt_pk_fp8_f32(clamp448(a6), clamp448(a7), w1, true);
    return (v2u){(unsigned)w0, (unsigned)w1};
}
__device__ __forceinline__ float bflo(unsigned w) { return __builtin_bit_cast(float, w << 16); }
__device__ __forceinline__ float bfhi(unsigned w) { return __builtin_bit_cast(float, w & 0xffff0000u); }
__device__ __forceinline__ float wave_sum(float v) {
#pragma unroll
    for (int o = 1; o < 64; o <<= 1) v += __shfl_xor(v, o);
    return v;
}
__device__ __forceinline__ float wave_max(float v) {
#pragma unroll
    for (int o = 1; o < 64; o <<= 1) v = fmaxf(v, __shfl_xor(v, o));
    return v;
}
__device__ __forceinline__ float swap_sum(float v) { auto rr = __builtin_amdgcn_permlane32_swap(__float_as_uint(v), __float_as_uint(v), false, false); return __uint_as_float(rr[0]) + __uint_as_float(rr[1]); }
__device__ __forceinline__ float fast_exp2(float x) { return __builtin_amdgcn_exp2f(x); }
__device__ __forceinline__ float sigmoidf_(float g) { return __builtin_amdgcn_rcpf(1.f + fast_exp2(-1.4426950408889634f * g)); }

#define XB_TMO      128
#define XB_XCNT(j)  (256  + 64 * (j))
#define XB_XSUB(j)  (1280 + 64 * (j))
#define XB_XGEN(j)  (2304 + 64 * (j))
#define XB_TOP      3328
#define XB_TOPGEN   3392
#define XCD_BAR_WORDS 3456
#define XB_SPIN_CAP (1u << 18)
__device__ __forceinline__ unsigned xb_ld(unsigned* p)              { return __hip_atomic_load(p, __ATOMIC_RELAXED, __HIP_MEMORY_SCOPE_AGENT); }
__device__ __forceinline__ unsigned xb_add(unsigned* p, unsigned v) { return __hip_atomic_fetch_add(p, v, __ATOMIC_RELAXED, __HIP_MEMORY_SCOPE_AGENT); }
__device__ __forceinline__ unsigned xb_xcc_id() { return (unsigned)__builtin_amdgcn_s_getreg((3 << 11) | 20) & 0xFu; }
#define XB_SPIN(cond, bar) do { unsigned _sp = 0; while (cond) { __builtin_amdgcn_s_sleep(1); \
    if ((++_sp & 255u) == 0u) { if (xb_ld(&(bar)[XB_TMO])) break; if (_sp > XB_SPIN_CAP) { atomicAdd(&(bar)[XB_TMO], 1u); break; } } } } while (0)
struct XcdBarrier { unsigned* bar; unsigned x; volatile LAS unsigned* st; };
__device__ __forceinline__ XcdBarrier xcd_barrier_post(unsigned* bar, volatile LAS unsigned* st) {
    XcdBarrier b; b.bar = bar; b.x = xb_xcc_id(); b.st = st;
    if (threadIdx.x == 0) (void)xb_add(&bar[XB_XCNT(b.x)], 1u);
    return b;
}
__device__ __forceinline__ void xcd_barrier_complete(unsigned* bar, unsigned x, unsigned& nloc, unsigned& nx) {
    const unsigned G = gridDim.x * gridDim.y * gridDim.z;
    unsigned sum, cnt, mine, sp = 0u;
    for (;;) {
        sum = 0u; cnt = 0u; mine = 0u;
#pragma unroll
        for (unsigned j = 0; j < 16; ++j) { const unsigned c = xb_ld(&bar[XB_XCNT(j)]); sum += c; cnt += (c > 0u) ? 1u : 0u; mine = (j == x) ? c : mine; }
        if (sum == G) break;
        __builtin_amdgcn_s_sleep(1);
        if ((++sp & 255u) == 0u) { if (xb_ld(&bar[XB_TMO])) break; if (sp > XB_SPIN_CAP) { atomicAdd(&bar[XB_TMO], 1u); break; } }
    }
    nloc = mine > 0u ? mine : 1u; nx = cnt > 0u ? cnt : 1u;
}
__device__ __forceinline__ void xcd_barrier(const XcdBarrier& b) {
    asm volatile("s_waitcnt vmcnt(0)" ::: "memory");
    __syncthreads();
    if (threadIdx.x == 0) {
        unsigned* bar = b.bar;
        __builtin_amdgcn_s_waitcnt(0);
        unsigned nloc = b.st[0], nx = b.st[1];
        if (nloc == 0u) { xcd_barrier_complete(bar, b.x, nloc, nx); b.st[0] = nloc; b.st[1] = nx; }
        const unsigned old = xb_add(&bar[XB_XSUB(b.x)], 1u);
        const unsigned gen = old / nloc;
        if (old + 1u == (gen + 1u) * nloc) {
            __builtin_amdgcn_fence(__ATOMIC_RELEASE, "agent");
            asm volatile("s_waitcnt vmcnt(0)" ::: "memory");
            const unsigned og = xb_add(&bar[XB_TOP], 1u);
            const unsigned tg = og / nx;
            if (og + 1u == (tg + 1u) * nx) xb_add(&bar[XB_TOPGEN], 1u);
            else XB_SPIN(xb_ld(&bar[XB_TOPGEN]) == tg, bar);
            __builtin_amdgcn_fence(__ATOMIC_ACQUIRE, "agent");
            xb_add(&bar[XB_XGEN(b.x)], 1u);
            asm volatile("s_waitcnt vmcnt(0)" ::: "memory");
        } else {
            XB_SPIN(xb_ld(&bar[XB_XGEN(b.x)]) == gen, bar);
            __builtin_amdgcn_fence(__ATOMIC_ACQUIRE, "agent");
            asm volatile("s_waitcnt vmcnt(0)" ::: "memory");
        }
    }
    __syncthreads();
}

namespace gm {
constexpr int BM = 256, BK = 64, HALF = 128, HTB = HALF * BK * 2, NXCD = 8, WGM = 8;
__host__ __device__ __forceinline__ int lds_byte(int r, int c) { const int st = (r >> 4) * 2 + (c >> 5), rr = r & 15, cc = c & 31, ob = rr * 64 + cc * 2; return st * 1024 + (ob ^ (((ob >> 9) & 1) << 5)); }
__host__ __device__ __forceinline__ void stage_rc(int b, int& R, int& C) { const int st = b / 1024, sb = b % 1024, swz = sb ^ (((sb >> 9) & 1) << 5); R = (st >> 1) * 16 + swz / 64; C = (st & 1) * 32 + (swz % 64) / 2; }
__host__ __device__ __forceinline__ int perm32(int rho) { const int n = rho >> 4, i = rho & 15; return 8 * (i >> 2) + 4 * n + (i & 3); }

struct Unit { int pm, pn, e, rt; };

struct DenseSched {
    const char* A; const char* Bt; int K, lda;
    int nM, nN, nwg, G, c;
    __device__ __forceinline__ void init(const void* A_, const void* Bt_, int M, int N, int K_, int lda_, int G_, int c_) { A = (const char*)A_; Bt = (const char*)Bt_; K = K_; lda = lda_; nM = M / BM; nN = N / BM; nwg = nM * nN; G = G_; c = c_; }
    __device__ __forceinline__ bool next(int i, Unit& u) const {
        const long L = (long)i * G + c; if (L >= nwg) return false;
        int wgid = (int)L; { const int q = nwg / NXCD, r = nwg % NXCD, xcd = wgid % NXCD, off = wgid / NXCD; wgid = (xcd < r ? xcd * (q + 1) : r * (q + 1) + (xcd - r) * q) + off; }
        const int nig = WGM * nN, gid = wgid / nig, fm = gid * WGM, gsz = (nM - fm) < WGM ? (nM - fm) : WGM;
        u.pm = fm + ((wgid % nig) % gsz); u.pn = (wgid % nig) / gsz; u.e = 0; u.rt = u.pm; return true;
    }
    __device__ __forceinline__ const char* b_tile(const Unit& u) const { return Bt + (size_t)u.pn * BM * K * 2; }
    static constexpr bool GATHER = false;
    __device__ __forceinline__ const char* a_tile(const Unit& u) const { return A + (size_t)u.pm * BM * lda * 2; }
    __device__ __forceinline__ void a_off(const Unit&, const int (&)[2], const int (&)[2], unsigned (&)[2][2]) const {}
};
template <bool GATH> struct MoeSched {
    static constexpr bool GATHER = GATH;
    const char* A; const char* Bt; int K, lda, N;
    int nct;
    const int* tokl;
    const LAS int* TS; const LAS int* EC;
    int grp, rank, cpg, epg;
    __device__ __forceinline__ bool next(int i, Unit& u) const {
        int L = i * cpg + rank;
        for (int q = 0; q < epg; ++q) {
            const int e = grp * epg + q; const int nt_e = __builtin_amdgcn_readfirstlane(TS[e + 1] - TS[e]); const int nu = nt_e * nct;
            if (L < nu) { u.e = e; u.rt = L / nct; u.pn = L % nct; u.pm = __builtin_amdgcn_readfirstlane(TS[e]) + u.rt; return true; }
            L -= nu;
        }
        return false;
    }
    __device__ __forceinline__ const char* b_tile(const Unit& u) const { return Bt + ((size_t)u.e * N + (size_t)u.pn * BM) * K * 2; }
    __device__ __forceinline__ const char* a_tile(const Unit& u) const { return A + (size_t)u.pm * BM * lda * 2; }
    __device__ __forceinline__ void a_off(const Unit& u, const int (&R)[2], const int (&C)[2], unsigned (&off)[2][2]) const {
        const int cnt = EC[u.e];
#pragma unroll
        for (int h = 0; h < 2; ++h)
#pragma unroll
            for (int i = 0; i < 2; ++i) { const int sl = u.rt * BM + h * HALF + R[i]; const int tok = (sl < cnt) ? tokl[(size_t)u.e * T + sl] : 0; off[h][i] = (unsigned)(((size_t)tok * lda + C[i]) * 2); }
    }
};

template <bool FP8, class Epi, class Sched>
__device__ __forceinline__ void gemm_phase(LAS unsigned char* lds, const Sched& S, const Epi& E) {
    const int tid = threadIdx.x, wid = __builtin_amdgcn_readfirstlane(tid >> 6), lane = tid & 63, wr = wid >> 2, wc = wid & 3, fr = lane & 15, fq = lane >> 4;
    const int K = S.K, nt = K / BK;
    int R[2], C[2]; unsigned voffB[2];
#pragma unroll
    for (int i = 0; i < 2; ++i) { stage_rc(tid * 16 + i * 8192, R[i], C[i]); const int Rb = (R[i] & ~31) + perm32(R[i] & 31); voffB[i] = (unsigned)(Rb * K + C[i]) * 2u; }
    const size_t kstep = (size_t)(BK * 2);
    const size_t hstepB = (size_t)HALF * K * 2;
    const unsigned ldsw = (unsigned)wid * 1024u;
    const int aoff = lds_byte(wr * 64 + fr, fq * 8), boff = lds_byte(wc * 32 + fr, fq * 8);
#define G_SA(b, h) (((b) * 2 + (h)) * HTB)
#define G_SB(b, h) ((4 + (b) * 2 + (h)) * HTB)
#define G_STAGE(bufoff, gbase, o0, o1) do { \
        __builtin_amdgcn_global_load_lds((const unsigned*)((const char*)(gbase) + (o0)), (LAS unsigned*)(lds + (bufoff) + ldsw), 16, 0, 0); \
        __builtin_amdgcn_global_load_lds((const unsigned*)((const char*)(gbase) + (o1)), (LAS unsigned*)(lds + (bufoff) + ldsw + 8192), 16, 0, 0); } while (0)
#define G_LDA(dst, b, h) do { _Pragma("unroll") for (int m = 0; m < 4; ++m) _Pragma("unroll") for (int k = 0; k < 2; ++k) dst[m][k] = *(const LAS bf16x8*)(lds + G_SA(b, h) + aoff + m * 2048 + k * 1024); } while (0)
#define G_LDB(dst, b, h) do { _Pragma("unroll") for (int n = 0; n < 2; ++n) _Pragma("unroll") for (int k = 0; k < 2; ++k) dst[n][k] = *(const LAS bf16x8*)(lds + G_SB(b, h) + boff + n * 2048 + k * 1024); } while (0)
#define G_CAT(x) __builtin_shufflevector(__builtin_bit_cast(v4i_t, x[0]), __builtin_bit_cast(v4i_t, x[1]), 0, 1, 2, 3, 4, 5, 6, 7)
#define G_MMA(ai, bj, At, Bt) do { __builtin_amdgcn_s_setprio(1); \
        if constexpr (FP8) { _Pragma("unroll") for (int m = 0; m < 4; ++m) _Pragma("unroll") for (int n = 0; n < 2; ++n) \
            asm volatile("v_mfma_scale_f32_16x16x128_f8f6f4 %0, %1, %2, %0, %3, %4 op_sel_hi:[0,0,0]" : "+v"(acc[ai][bj][m][n]) : "v"(G_CAT(Bt[n])), "v"(G_CAT(At[m])), "v"(sc_w), "v"(sc_a)); } \
        else { _Pragma("unroll") for (int m = 0; m < 4; ++m) _Pragma("unroll") for (int n = 0; n < 2; ++n) _Pragma("unroll") for (int k = 0; k < 2; ++k) \
            acc[ai][bj][m][n] = __builtin_amdgcn_mfma_f32_16x16x32_bf16(Bt[n][k], At[m][k], acc[ai][bj][m][n], 0, 0, 0); } \
        __builtin_amdgcn_s_setprio(0); } while (0)
#define G_WAIT_V(n) asm volatile("s_waitcnt vmcnt(" #n ")" ::: "memory")
#define G_WAIT_L(n) asm volatile("s_waitcnt lgkmcnt(" #n ")" ::: "memory")
#define G_BAR __builtin_amdgcn_s_barrier()
#define G_SCHED __builtin_amdgcn_sched_barrier(0)
    Unit cur, nxt; int ui = 0;
    if (!S.next(0, cur)) return;
    f32x4 acc[2][2][4][2];
#pragma unroll
    for (int a = 0; a < 2; ++a)
#pragma unroll
        for (int b = 0; b < 2; ++b)
#pragma unroll
            for (int m = 0; m < 4; ++m)
#pragma unroll
                for (int n = 0; n < 2; ++n) acc[a][b][m][n] = (f32x4){0.f, 0.f, 0.f, 0.f};
    bf16x8 At[4][2], B0[2][2], B1[2][2];
    const int sc_w = 0x77777777, sc_a = 0x7f7f7f7f;
    unsigned off[2][2], noff[2][2]; unsigned voffA[2];
    const size_t hstepA = (size_t)HALF * S.lda * 2;
    const char* cA = S.A; const char* nA = S.A;
    if constexpr (Sched::GATHER) { S.a_off(cur, R, C, off); voffA[0] = voffA[1] = 0u; }
    else { cA = S.a_tile(cur); voffA[0] = (unsigned)(R[0] * S.lda + C[0]) * 2u; voffA[1] = (unsigned)(R[1] * S.lda + C[1]) * 2u; off[0][0] = off[0][1] = off[1][0] = off[1][1] = 0u; noff[0][0] = noff[0][1] = noff[1][0] = noff[1][1] = 0u; }
#define G_STAGE_A(bufoff, h, ktb, NX) do { \
        if constexpr (Sched::GATHER) { G_STAGE(bufoff, cA + (ktb), (NX) ? noff[h][0] : off[h][0], (NX) ? noff[h][1] : off[h][1]); } \
        else { G_STAGE(bufoff, ((NX) ? nA : cA) + (h) * hstepA + (ktb), voffA[0], voffA[1]); } } while (0)
    const char* cB = S.b_tile(cur);
    G_STAGE(G_SB(0, 0), cB, voffB[0], voffB[1]); G_STAGE(G_SB(0, 1), cB + hstepB, voffB[0], voffB[1]); G_STAGE_A(G_SA(0, 0), 0, 0, false); G_STAGE_A(G_SA(0, 1), 1, 0, false);
    if (wr == 1) G_BAR;
    G_WAIT_V(2); G_BAR;
    G_STAGE(G_SB(1, 0), cB + kstep, voffB[0], voffB[1]); G_STAGE_A(G_SA(1, 0), 0, kstep, false); G_STAGE(G_SB(1, 1), cB + hstepB + kstep, voffB[0], voffB[1]);
    G_WAIT_V(6); G_BAR;
    for (;;) {
        const bool has_next = S.next(ui + 1, nxt);
        if constexpr (Sched::GATHER) { if (has_next) S.a_off(nxt, R, C, noff); else { noff[0][0] = off[0][0]; noff[0][1] = off[0][1]; noff[1][0] = off[1][0]; noff[1][1] = off[1][1]; } }
        else nA = has_next ? S.a_tile(nxt) : cA;
        const char* nB = has_next ? S.b_tile(nxt) : cB;
        for (int t = 0; t < nt; t += 2) {
            const bool last = (t == nt - 2);
            const size_t k1 = (size_t)(t + 1) * kstep;
            const size_t k2 = last ? 0 : (size_t)(t + 2) * kstep, k3 = k2 + kstep;
            const char* b2 = last ? nB : cB + (size_t)(t + 2) * kstep; const char* b3 = b2 + kstep;
            G_LDB(B0, 0, 0); G_LDB(B1, 0, 1); G_SCHED; G_LDA(At, 0, 0); G_STAGE_A(G_SA(1, 1), 1, k1, false);
            G_WAIT_V(8); G_WAIT_L(0); G_BAR; G_MMA(0, 0, At, B0); G_MMA(0, 1, At, B1); G_BAR; G_SCHED;
            G_LDA(At, 0, 1); G_STAGE(G_SB(0, 0), b2, voffB[0], voffB[1]); G_STAGE(G_SB(0, 1), b2 + hstepB, voffB[0], voffB[1]); G_STAGE_A(G_SA(0, 0), 0, k2, last);
            G_WAIT_V(8); G_WAIT_L(0); G_BAR; G_MMA(1, 0, At, B0); G_MMA(1, 1, At, B1); G_BAR; G_SCHED;
            G_LDB(B0, 1, 0); G_LDB(B1, 1, 1); G_SCHED; G_LDA(At, 1, 0); G_STAGE_A(G_SA(0, 1), 1, k2, last);
            G_WAIT_V(8); G_WAIT_L(0); G_BAR; G_MMA(0, 0, At, B0); G_MMA(0, 1, At, B1); G_BAR; G_SCHED;
            G_LDA(At, 1, 1); G_STAGE(G_SB(1, 0), b3, voffB[0], voffB[1]); G_STAGE(G_SB(1, 1), b3 + hstepB, voffB[0], voffB[1]); G_STAGE_A(G_SA(1, 0), 0, k3, last);
            G_WAIT_V(8); G_WAIT_L(0); G_BAR; G_MMA(1, 0, At, B0); G_MMA(1, 1, At, B1); G_BAR; G_SCHED;
        }
        if (wr == 0) G_BAR;
        if constexpr (FP8) asm volatile("s_nop 15\n\ts_nop 15" ::: "memory");
        { int fr_e = fr, fq_e = fq; asm volatile("" : "+v"(fr_e), "+v"(fq_e));
          E(acc, cur, wr, wc, fr_e, fq_e); }
        if (!has_next) break;
#pragma unroll
        for (int a = 0; a < 2; ++a)
#pragma unroll
            for (int b = 0; b < 2; ++b)
#pragma unroll
                for (int m = 0; m < 4; ++m)
#pragma unroll
                    for (int n = 0; n < 2; ++n) acc[a][b][m][n] = (f32x4){0.f, 0.f, 0.f, 0.f};
        cur = nxt; cB = nB; ++ui;
        if constexpr (Sched::GATHER) { off[0][0] = noff[0][0]; off[0][1] = noff[0][1]; off[1][0] = noff[1][0]; off[1][1] = noff[1][1]; } else cA = nA;
        if (wr == 1) G_BAR;
    }
    G_WAIT_V(0);
    G_BAR;
#undef G_SA
#undef G_SB
#undef G_STAGE
#undef G_STAGE_A
#undef G_LDA
#undef G_LDB
#undef G_MMA
#undef G_CAT
#undef G_WAIT_V
#undef G_WAIT_L
#undef G_BAR
#undef G_SCHED
}

typedef f32x4 Acc[2][2][4][2];
__device__ __forceinline__ v4u pack8(const f32x4 a, const f32x4 b) { v4u w; w.x = pk2(a[0], a[1]); w.y = pk2(a[2], a[3]); w.z = pk2(b[0], b[1]); w.w = pk2(b[2], b[3]); return w; }

struct EpiPlain {
    bf16* O; int ldc;
    __device__ __forceinline__ void operator()(const Acc& acc, const Unit& u, int wr, int wc, int fr, int fq) const {
        const int row0 = u.pm * BM + wr * 64 + fr, col0 = u.pn * BM + wc * 32 + 8 * fq;
#pragma unroll
        for (int ai = 0; ai < 2; ++ai)
#pragma unroll
            for (int m = 0; m < 4; ++m) { bf16* rowp = O + (size_t)(row0 + ai * HALF + m * 16) * ldc + col0;
#pragma unroll
                for (int bj = 0; bj < 2; ++bj) *(v4u*)(rowp + bj * HALF) = pack8(acc[ai][bj][m][0], acc[ai][bj][m][1]); }
    }
};
struct EpiIn {
    bf16* CQKV; bf16* Y; float* KPE;
    __device__ __forceinline__ void operator()(const Acc& acc, const Unit& u, int wr, int wc, int fr, int fq) const {
        const int row0 = u.pm * BM + wr * 64 + fr;
        if (u.pn < 2) {
#pragma unroll
            for (int ai = 0; ai < 2; ++ai)
#pragma unroll
                for (int m = 0; m < 4; ++m) { bf16* rowp = CQKV + (size_t)(row0 + ai * HALF + m * 16) * 512 + u.pn * BM + wc * 32 + 8 * fq;
#pragma unroll
                    for (int bj = 0; bj < 2; ++bj) *(v4u*)(rowp + bj * HALF) = pack8(acc[ai][bj][m][0], acc[ai][bj][m][1]); }
        } else if (u.pn < 6) {
            const int cb = (u.pn - 2) * 128 + wc * 32 + 8 * fq;
#pragma unroll
            for (int ai = 0; ai < 2; ++ai)
#pragma unroll
                for (int m = 0; m < 4; ++m) {
                    f32x4 y0, y1;
#pragma unroll
                    for (int i = 0; i < 4; ++i) { y0[i] = acc[ai][0][m][0][i] * sigmoidf_(acc[ai][1][m][0][i]); y1[i] = acc[ai][0][m][1][i] * sigmoidf_(acc[ai][1][m][1][i]); }
                    *(v4u*)(Y + (size_t)(row0 + ai * HALF + m * 16) * 512 + cb) = pack8(y0, y1); }
        } else {
            if (wc == 0) {
#pragma unroll
                for (int ai = 0; ai < 2; ++ai)
#pragma unroll
                    for (int m = 0; m < 4; ++m) { float* p = KPE + (size_t)(row0 + ai * HALF + m * 16) * 32 + 8 * fq; *(f32x4*)p = acc[ai][0][m][0]; *(f32x4*)(p + 4) = acc[ai][0][m][1]; }
            }
        }
    }
};
struct EpiKV {
    bf16* KF; bf16* VF; const float* rskv; const float* kss; const float* kr; const float* gk;
    __device__ __forceinline__ void operator()(const Acc& acc, const Unit& u, int wr, int wc, int fr, int fq) const {
        const int row0 = u.pm * BM + wr * 64 + fr; const int head = 2 * u.pn + (wc & 1);
        if (wc < 2) {
#pragma unroll
            for (int ai = 0; ai < 2; ++ai)
#pragma unroll
                for (int m = 0; m < 4; ++m) { const int row = row0 + ai * HALF + m * 16; const float rs = rskv[row];
                    float ss = 0.f;
#pragma unroll
                    for (int bj = 0; bj < 2; ++bj)
#pragma unroll
                        for (int n = 0; n < 2; ++n) { const f32x4 q = acc[ai][bj][m][n]; ss += (q[0] * q[0] + q[1] * q[1]) + (q[2] * q[2] + q[3] * q[3]); }
                    ss += __shfl_xor(ss, 16); ss += __shfl_xor(ss, 32);
                    const float rn = __builtin_amdgcn_rsqf((ss * rs * rs + kss[row]) * (1.f / 96.f) + EPS); const float sc = rs * rn;
                    bf16* kp = KF + (size_t)row * 768 + head * 96;
#pragma unroll
                    for (int bj = 0; bj < 2; ++bj) { const f32x4 g0 = *(const f32x4*)(gk + 32 * bj + 8 * fq), g1 = *(const f32x4*)(gk + 32 * bj + 8 * fq + 4);
                        *(v4u*)(kp + 32 * bj + 8 * fq) = pack8(acc[ai][bj][m][0] * g0 * sc, acc[ai][bj][m][1] * g1 * sc); }
                    const f32x4 r0 = *(const f32x4*)(kr + (size_t)row * 32 + 8 * fq), r1 = *(const f32x4*)(kr + (size_t)row * 32 + 8 * fq + 4);
                    *(v4u*)(kp + 64 + 8 * fq) = pack8(r0 * rn, r1 * rn); asm volatile("" ::: "memory"); }
        } else {
#pragma unroll
            for (int ai = 0; ai < 2; ++ai)
#pragma unroll
                for (int m = 0; m < 4; ++m) { const int row = row0 + ai * HALF + m * 16; const float rs = rskv[row]; bf16* vp = VF + (size_t)row * 512 + head * 64 + 8 * fq;
#pragma unroll
                    for (int bj = 0; bj < 2; ++bj) *(v4u*)(vp + 32 * bj) = pack8(acc[ai][bj][m][0] * rs, acc[ai][bj][m][1] * rs); asm volatile("" ::: "memory"); }
        }
    }
};
struct EpiX1 {
    const float* X; float* OUT; unsigned char* X1Q;
    __device__ __forceinline__ void operator()(const Acc& acc, const Unit& u, int wr, int wc, int fr, int fq) const {
        const int row0 = u.pm * BM + wr * 64 + fr, col0 = u.pn * BM + wc * 32 + 8 * fq;
#pragma unroll
        for (int ai = 0; ai < 2; ++ai)
#pragma unroll
            for (int m = 0; m < 4; ++m) { const size_t o = (size_t)(row0 + ai * HALF + m * 16) * D + col0;
#pragma unroll
                for (int bj = 0; bj < 2; ++bj) { const f32x4 a = acc[ai][bj][m][0] + *(const f32x4*)(X + o + bj * HALF), b = acc[ai][bj][m][1] + *(const f32x4*)(X + o + bj * HALF + 4);
                    *(f32x4*)(OUT + o + bj * HALF) = a; *(f32x4*)(OUT + o + bj * HALF + 4) = b; *(v2u*)(X1Q + o + bj * HALF) = pack8_fp8(a[0], a[1], a[2], a[3], b[0], b[1], b[2], b[3]); } asm volatile("" ::: "memory"); }
    }
};
struct EpiGU {
    unsigned char* ACT; const float* bgu; const float* rsl; const LAS int* EC;
    __device__ __forceinline__ void operator()(const Acc& acc, const Unit& u, int wr, int wc, int fr, int fq) const {
        const int r0 = wr * 64 + fr; const int cb = u.pn * 128 + wc * 32 + 8 * fq; const int cnt = EC[u.e];
        const float* bg = bgu + (size_t)u.e * 2048 + cb;
        const f32x4 bg0 = *(const f32x4*)bg, bg1 = *(const f32x4*)(bg + 4), bu0 = *(const f32x4*)(bg + 1024), bu1 = *(const f32x4*)(bg + 1028);
#pragma unroll
        for (int ai = 0; ai < 2; ++ai)
#pragma unroll
            for (int m = 0; m < 4; ++m) { const int rr = r0 + ai * HALF + m * 16; const int sl = u.rt * BM + rr;
                const float rs = (sl < cnt) ? rsl[(size_t)u.e * T + sl] : 0.f;
                f32x4 o[2];
#pragma unroll
                for (int n = 0; n < 2; ++n) { const f32x4 gb = n ? bg1 : bg0, ub = n ? bu1 : bu0;
#pragma unroll
                    for (int i = 0; i < 4; ++i) { float gt = fminf(acc[ai][0][m][n][i] * rs + gb[i], 7.f); float up = fminf(fmaxf(acc[ai][1][m][n][i] * rs + ub[i], -7.f), 7.f);
                        o[n][i] = (up + 1.f) * gt * sigmoidf_(1.702f * gt); } }
                *(v2u*)(ACT + (size_t)(u.pm * BM + rr) * 1024 + cb) = pack8_fp8(o[0][0], o[0][1], o[0][2], o[0][3], o[1][0], o[1][1], o[1][2], o[1][3]); asm volatile("" ::: "memory"); }
    }
};
struct EpiDown {
    bf16* YS; const float* bd;
    __device__ __forceinline__ void operator()(const Acc& acc, const Unit& u, int wr, int wc, int fr, int fq) const {
        const int row0 = u.pm * BM + wr * 64 + fr, col0 = u.pn * BM + wc * 32 + 8 * fq;
        f32x4 b[2][2];
#pragma unroll
        for (int bj = 0; bj < 2; ++bj) { b[bj][0] = *(const f32x4*)(bd + (size_t)u.e * 1024 + col0 + bj * HALF); b[bj][1] = *(const f32x4*)(bd + (size_t)u.e * 1024 + col0 + bj * HALF + 4); }
#pragma unroll
        for (int ai = 0; ai < 2; ++ai)
#pragma unroll
            for (int m = 0; m < 4; ++m) { bf16* rowp = YS + (size_t)(row0 + ai * HALF + m * 16) * 1024 + col0;
#pragma unroll
                for (int bj = 0; bj < 2; ++bj) *(v4u*)(rowp + bj * HALF) = pack8(acc[ai][bj][m][0] + b[bj][0], acc[ai][bj][m][1] + b[bj][1]); }
    }
};
}

struct Args {
    const float* x; const int* positions; const float* norm_mix_g; const float* w_in; const float* q_latent_g; const float* w_uq; const float* kv_latent_g; const float* w_ukv;
    const float* q_head_g; const float* k_head_g; const float* conv_dw_w; const float* conv_dw_b; const float* conv_ln_g; const float* conv_ln_b; const float* attn_out_g; const float* conv_out_g;
    const float* w_out; const float* norm_ffn_g; const float* router_w; const float* router_b; const float* w_gate_up; const float* b_gate_up; const float* w_down; const float* b_down;
    float* out; unsigned char* ws; int ph_lo, ph_hi, li, pad;
};

__device__ __forceinline__ void tr_item(const float* __restrict__ W, int ldw, int n0s, const float* __restrict__ gain, bf16* WT, int K, int n0d, int k0, LAS float* scr, int lane) {
    const int c = lane & 7;
    if (n0s < 0) {
#pragma unroll
        for (int j = 0; j < 4; ++j) { const int n = (lane >> 3) + 8 * j; *(GAS v4u*)(WT + (size_t)(n0d + n) * K + k0 + 8 * c) = (v4u){0u, 0u, 0u, 0u}; }
        return;
    }
    float v[32];
#pragma unroll
    for (int i = 0; i < 32; ++i) { const int kk = 2 * i + (lane >> 5); v[i] = W[(size_t)(k0 + kk) * ldw + n0s + (lane & 31)]; }
    if (gain) {
#pragma unroll
        for (int i = 0; i < 32; ++i) v[i] *= gain[k0 + 2 * i + (lane >> 5)];
    }
#pragma unroll
    for (int i = 0; i < 32; ++i) { const int kk = 2 * i + (lane >> 5); scr[kk * 33 + (lane & 31)] = v[i]; }
    LDS_WAIT(); asm volatile("" ::: "memory");
#pragma unroll
    for (int j = 0; j < 4; ++j) { const int n = (lane >> 3) + 8 * j; const LAS float* s = scr + (8 * c) * 33 + n;
        v4u o; o.x = pk2(s[0 * 33], s[1 * 33]); o.y = pk2(s[2 * 33], s[3 * 33]); o.z = pk2(s[4 * 33], s[5 * 33]); o.w = pk2(s[6 * 33], s[7 * 33]);
        *(GAS v4u*)(WT + (size_t)(n0d + n) * K + k0 + 8 * c) = o; }
    LDS_WAIT(); asm volatile("" ::: "memory");
}

__device__ __forceinline__ void tr_item8(const float* __restrict__ W, int ldw, int n0s, const float* __restrict__ gain, unsigned char* WT, int K, int n0d, int k0, LAS float* scr, int lane) {
    const int c = lane & 7;
#pragma unroll 1
    for (int hh = 0; hh < 2; ++hh) { const int kb = k0 + 64 * hh;
        float v[32];
#pragma unroll
        for (int i = 0; i < 32; ++i) { const int kk = 2 * i + (lane >> 5); v[i] = W[(size_t)(kb + kk) * ldw + n0s + (lane & 31)]; }
        if (gain) {
#pragma unroll
            for (int i = 0; i < 32; ++i) v[i] *= gain[kb + 2 * i + (lane >> 5)];
        }
#pragma unroll
        for (int i = 0; i < 32; ++i) { const int kk = 2 * i + (lane >> 5); scr[kk * 33 + (lane & 31)] = v[i] * 256.f; }
        LDS_WAIT(); asm volatile("" ::: "memory");
#pragma unroll
        for (int j = 0; j < 4; ++j) { const int n = (lane >> 3) + 8 * j; const LAS float* s = scr + (8 * c) * 33 + n;
            *(GAS v2u*)(WT + (size_t)(n0d + n) * K + kb + 8 * c) = pack8_fp8(s[0 * 33], s[1 * 33], s[2 * 33], s[3 * 33], s[4 * 33], s[5 * 33], s[6 * 33], s[7 * 33]); }
        LDS_WAIT(); asm volatile("" ::: "memory");
    }
}

__device__ __forceinline__ void p0_prologue(const Args& a, LAS unsigned char* lds, int vcu, int G, int wave, int lane, int tid) {
    unsigned char* ws = a.ws;
    LAS float* scr = (LAS float*)(lds + wave * 16384);
    const int gw = vcu * 8 + wave, NGW = G * 8;
    constexpr int I_IN = 16 * 56, I_UQ = 6 * 24, I_UKV = 2 * 32, I_OUT = 16 * 32, I_GU = 32 * 512, I_D = 32 * 256;
    constexpr int NITEMS = I_IN + I_UQ + I_UKV + I_OUT + I_GU + I_D;
    for (int it = gw; it < NITEMS; it += NGW) {
        int r = it;
        if (r < I_GU) {
            const int e = r >> 9, r2 = r & 511, nb = r2 & 63, kb = r2 >> 6, tn = nb >> 3, w = nb & 7;
            const int src = (w < 4) ? (128 * tn + 32 * w) : (1024 + 128 * tn + 32 * (w - 4));
            tr_item8(a.w_gate_up + (size_t)e * 1024 * 2048, 2048, src, a.norm_ffn_g, ws + WS_WGU8 + (size_t)e * 2048 * 1024, 1024, 32 * nb, 128 * kb, scr, lane); continue; }
        r -= I_GU;
        if (r < I_D) { const int e = r >> 8, r2 = r & 255, nb = r2 & 31, kb = r2 >> 5;
            tr_item8(a.w_down + (size_t)e * 1024 * 1024, 1024, 32 * nb, nullptr, ws + WS_WD8 + (size_t)e * 1024 * 1024, 1024, 32 * nb, 128 * kb, scr, lane); continue; }
        r -= I_D;
        if (r < I_IN) { const int nb = r % 56, kb = r / 56; int src;
            if (nb < 16) src = 32 * nb; else if (nb < 48) { const int tn = (nb - 16) >> 3, w = (nb - 16) & 7; src = (w < 4) ? (544 + 128 * tn + 32 * w) : (544 + 512 + 128 * tn + 32 * (w - 4)); } else if (nb == 48) src = 512; else src = -1;
            tr_item(a.w_in, INW, src, nullptr, (bf16*)(ws + WS_WIN), 1024, 32 * nb, 64 * kb, scr, lane); continue; }
        r -= I_IN;
        if (r < I_UQ) { const int nb = r % 24, kb = r / 24; tr_item(a.w_uq, 768, 32 * nb, a.q_latent_g, (bf16*)(ws + WS_WUQ), QL, 32 * nb, 64 * kb, scr, lane); continue; }
        r -= I_UQ;
        if (r < I_UKV) { const int nb = r % 32, kb = r / 32, tn = nb >> 3, w = nb & 7, bj = w >> 2, wc = w & 3; const int head = 2 * tn + (wc & 1), isv = wc >> 1;
            tr_item(a.w_ukv, 1024, head * 128 + isv * 64 + 32 * bj, a.kv_latent_g, (bf16*)(ws + WS_WUKV), KVL, 32 * nb, 64 * kb, scr, lane); continue; }
        r -= I_UKV;
        { const int nb = r % 32, kb = r / 32; tr_item(a.w_out, 1024, 32 * nb, nullptr, (bf16*)(ws + WS_WOUT), 1024, 32 * nb, 64 * kb, scr, lane); }
    }
    {
        f32x4 g[4];
#pragma unroll
        for (int j = 0; j < 4; ++j) g[j] = ((const f32x4*)a.norm_mix_g)[lane + 64 * j];
        bf16* H1 = (bf16*)(ws + WS_H1);
        for (int m = gw; m < T; m += NGW) {
            const GAS f32x4* xr = (const GAS f32x4*)(a.x + (size_t)m * D) + lane;
            f32x4 v[4]; float s = 0.f;
#pragma unroll
            for (int j = 0; j < 4; ++j) { v[j] = xr[64 * j]; s += (v[j].x * v[j].x + v[j].y * v[j].y) + (v[j].z * v[j].z + v[j].w * v[j].w); }
            const float rstd = __builtin_amdgcn_rsqf(wave_sum(s) * (1.f / D) + EPS);
            GAS v2u* o8 = (GAS v2u*)(H1 + (size_t)m * D) + lane;
#pragma unroll
            for (int j = 0; j < 4; ++j) { v2u w; w.x = pk2(v[j].x * rstd * g[j].x, v[j].y * rstd * g[j].y); w.y = pk2(v[j].z * rstd * g[j].z, v[j].w * rstd * g[j].w); o8[64 * j] = w; }
        }
    }
    {
        const int gt = vcu * 512 + tid, NT_ = G * 512;
        f32x2* cs = (f32x2*)(ws + WS_CS);
        for (int idx = gt; idx < T * 16; idx += NT_) {
            const int t = idx >> 4, i = idx & 15;
            const float p4[4] = {1.0f, 1.7782794100389228f, 3.1622776601683795f, 5.623413251903491f};
            float pw = p4[i & 3]; const int dec = i >> 2; pw *= (dec == 0 ? 1.f : dec == 1 ? 10.f : dec == 2 ? 100.f : 1000.f);
            const float inv = 1.0f / pw;
            const float ang = (float)a.positions[t] * inv;
            const double rev = (double)ang * 0.15915494309189535; const double fr = rev - __builtin_rint(rev);
            float sn, cn; sincospif((float)(2.0 * fr), &sn, &cn);
            cs[idx] = (f32x2){cn, sn};
        }
        bf16* RT = (bf16*)(ws + WS_RT);
        for (int idx = gt; idx < 1024 * 32; idx += NT_) {
            const int k = idx >> 5, e = idx & 31; const float v = a.norm_ffn_g[k] * a.router_w[idx];
            const unsigned hi = pk2(v, 0.f) & 0xffffu; const float lo = v - bflo(hi);
            const int s = k >> 5, kq = (k >> 3) & 3, j = k & 7; const int di = ((s * 4 + kq) * 32 + e) * 8 + j;
            RT[di] = (bf16)hi; RT[32768 + di] = (bf16)(pk2(lo, 0.f) & 0xffffu);
        }
    }
}

__device__ __forceinline__ void p2_thin(const Args& a, LAS unsigned char* lds, int vcu, int G, int wave, int lane, int tid) {
    unsigned char* ws = a.ws;
    LAS float* wl = (LAS float*)lds;
    for (int i = tid; i < 32 * 512 / 4; i += 512) ((LAS f32x4*)wl)[i] = (i < CK * 512 / 4) ? ((const f32x4*)a.conv_dw_w)[i] : (f32x4){0.f, 0.f, 0.f, 0.f};
    __syncthreads();
    const bf16* CQKV = (const bf16*)(ws + WS_CQKV); const bf16* Y = (const bf16*)(ws + WS_Y); const float* KPE = (const float*)(ws + WS_KPE);
    float* RSQ = (float*)(ws + WS_RSQ); float* RSKV = (float*)(ws + WS_RSKV); float* KSS = (float*)(ws + WS_KSS); float* KR = (float*)(ws + WS_KR);
    const f32x2* CS = (const f32x2*)(ws + WS_CS); bf16* MIX = (bf16*)(ws + WS_MIX);
    const int c0 = 8 * lane;
    float dwb[8], lng[8], lnb[8], cog[8];
#pragma unroll
    for (int i = 0; i < 8; ++i) { dwb[i] = a.conv_dw_b[c0 + i]; lng[i] = a.conv_ln_g[c0 + i]; lnb[i] = a.conv_ln_b[c0 + i]; cog[i] = a.conv_out_g[c0 + i]; }
    const float gk1 = a.k_head_g[64 + (lane & 15)], gk2 = a.k_head_g[80 + (lane & 15)];
    const int gw = vcu * 8 + wave, NGW = G * 8;
    for (int blk = gw; blk < T / 4; blk += NGW) {
        const int t0 = blk * 4, tb = t0 & (S - 1);
#pragma unroll
        for (int r = 0; r < 4; ++r) { const int row = t0 + r;
            const v4u w = *(const v4u*)(CQKV + (size_t)row * 512 + c0);
            float ss = 0.f;
#pragma unroll
            for (int i = 0; i < 4; ++i) { const float lo = bflo(w[i]), hi = bfhi(w[i]); ss += lo * lo + hi * hi; }
            const float sq = wave_sum(lane < 48 ? ss : 0.f), skv = wave_sum(lane >= 48 ? ss : 0.f);
            const float kv = (lane < 32) ? KPE[(size_t)row * 32 + lane] : 0.f;
            const float ks = wave_sum(kv * kv);
            const float x1 = gk1 * __shfl(kv, lane & 15), x2 = gk2 * __shfl(kv, 16 + (lane & 15));
            const f32x2 cs = CS[(size_t)row * 16 + (lane & 15)];
            if (lane < 16) KR[(size_t)row * 32 + lane] = x1 * cs.x - x2 * cs.y;
            else if (lane < 32) KR[(size_t)row * 32 + lane] = x2 * cs.x + x1 * cs.y;
            if (lane == 0) { RSQ[row] = __builtin_amdgcn_rsqf(sq * (1.f / QL) + EPS); RSKV[row] = __builtin_amdgcn_rsqf(skv * (1.f / KVL) + EPS); KSS[row] = ks; }
        }
        float acc[4][8];
#pragma unroll
        for (int r = 0; r < 4; ++r)
#pragma unroll
            for (int i = 0; i < 8; ++i) acc[r][i] = dwb[i];
        float win[4][8];
#define LOADROW(dst, q) do { v4u w_ = (v4u){0u, 0u, 0u, 0u}; if (tb + (q) >= 0) w_ = *(const v4u*)(Y + (size_t)(t0 + (q)) * 512 + c0); \
            _Pragma("unroll") for (int i_ = 0; i_ < 4; ++i_) { dst[2 * i_] = bflo(w_[i_]); dst[2 * i_ + 1] = bfhi(w_[i_]); } } while (0)
        LOADROW(win[0], -30); LOADROW(win[1], -29); LOADROW(win[2], -28);
#pragma unroll 1
        for (int jb = 0; jb < 32; jb += 4) {
#pragma unroll
            for (int jj = 0; jj < 4; ++jj) { const int j = jb + jj;
                if (j - 27 < 4) LOADROW(win[(jj + 3) & 3], j - 27);
                const f32x4 w0 = *(const LAS f32x4*)(wl + j * 512 + c0), w1 = *(const LAS f32x4*)(wl + j * 512 + c0 + 4);
#pragma unroll
                for (int r = 0; r < 4; ++r)
#pragma unroll
                    for (int i = 0; i < 8; ++i) acc[r][i] += (i < 4 ? w0[i] : w1[i - 4]) * win[(jj + r) & 3][i];
            }
            asm volatile("" ::: "memory");
        }
#undef LOADROW
#pragma unroll
        for (int r = 0; r < 4; ++r) {
            float s1 = 0.f;
#pragma unroll
            for (int i = 0; i < 8; ++i) s1 += acc[r][i];
            const float mean = wave_sum(s1) * (1.f / CW);
            float s2 = 0.f;
#pragma unroll
            for (int i = 0; i < 8; ++i) { acc[r][i] -= mean; s2 += acc[r][i] * acc[r][i]; }
            const float rstd = __builtin_amdgcn_rsqf(wave_sum(s2) * (1.f / CW) + EPS);
            float s3 = 0.f;
#pragma unroll
            for (int i = 0; i < 8; ++i) { const float z = acc[r][i] * rstd * lng[i] + lnb[i]; const float sg = z * sigmoidf_(z); acc[r][i] = sg; s3 += sg * sg; }
            const float r3 = __builtin_amdgcn_rsqf(wave_sum(s3) * (1.f / CW) + EPS);
            v4u o;
#pragma unroll
            for (int i = 0; i < 4; ++i) o[i] = pk2(acc[r][2 * i] * r3 * cog[2 * i], acc[r][2 * i + 1] * r3 * cog[2 * i + 1]);
            *(v4u*)(MIX + (size_t)(t0 + r) * 1024 + 512 + c0) = o;
        }
    }
}

namespace at {
constexpr int KSLOT = 12288, VSLOT = 8192, NSLOT = 3;
constexpr int L_K = 0, L_V = NSLOT * KSLOT, L_WS = L_V + NSLOT * VSLOT, L_OST = L_WS + 8 * 64 * 4, L_END = L_OST + 8 * 4096;
static_assert(L_END <= RING_BYTES, "attention LDS");
__device__ __forceinline__ int crow(int r, int hi) { return (r & 3) + 8 * (r >> 2) + 4 * hi; }
__device__ __forceinline__ void glds16(const void* gsrc, unsigned lds_dst) { unsigned keep;
    asm volatile("s_mov_b32 %0, m0\n\ts_mov_b32 m0, %2\n\ts_nop 0\n\tglobal_load_lds_dwordx4 %1, off\n\ts_mov_b32 m0, %0" : "=&s"(keep) : "v"(gsrc), "s"(lds_dst) : "memory"); }
typedef short v4i16_t __attribute__((ext_vector_type(4)));
__device__ __forceinline__ s16x4 vtr(const LAS char* p) { return __builtin_bit_cast(s16x4, __builtin_amdgcn_ds_read_tr16_b64_v4i16((LAS v4i16_t*)p)); }

__device__ __forceinline__ void attn_unit(const Args& a, int b, int h, int qb, LAS unsigned char* shm3) {
    unsigned char* ws = a.ws;
    const bf16* QRAW = (const bf16*)(ws + WS_QRAW); const bf16* KF = (const bf16*)(ws + WS_KF); const bf16* VF = (const bf16*)(ws + WS_VF); bf16* AO = (bf16*)(ws + WS_AO);
    const float* RSQ = (const float*)(ws + WS_RSQ); const f32x2* CS = (const f32x2*)(ws + WS_CS);
    const int tid = threadIdx.x, lane = tid & 63, r32 = lane & 31, hi = lane >> 5; const int wid = __builtin_amdgcn_readfirstlane(tid >> 6);
    const long rowbase = (long)b * S; const int q0 = qb * 256;
    const int NT = 4 * qb + 4, my_nt = 4 * qb + (wid >> 1) + 1;
    const long myrow = rowbase + q0 + wid * 32 + r32;
    const unsigned lds0 = (unsigned)(uintptr_t)shm3;
    bf16x8 qr[6]; f32x16 negm;
    {
        const bf16* qp = QRAW + myrow * 768 + h * 96 + 8 * hi;
        float f[6][8]; float ss = 0.f;
#pragma unroll
        for (int d0 = 0; d0 < 6; ++d0) { const v4u w = *(const v4u*)(qp + 16 * d0);
#pragma unroll
            for (int i = 0; i < 4; ++i) { f[d0][2 * i] = bflo(w[i]); f[d0][2 * i + 1] = bfhi(w[i]); ss += f[d0][2 * i] * f[d0][2 * i] + f[d0][2 * i + 1] * f[d0][2 * i + 1]; } }
        ss = swap_sum(ss);
        const float rq = RSQ[myrow];
        const float rn = rq * __builtin_amdgcn_rsqf(rq * rq * ss * (1.f / 96.f) + EPS);
#pragma unroll
        for (int d0 = 0; d0 < 6; ++d0) { const f32x4 g0 = *(const f32x4*)(a.q_head_g + 16 * d0 + 8 * hi), g1 = *(const f32x4*)(a.q_head_g + 16 * d0 + 8 * hi + 4);
#pragma unroll
            for (int i = 0; i < 4; ++i) { f[d0][i] *= rn * g0[i]; f[d0][4 + i] *= rn * g1[i]; } }
        const f32x2* csr = CS + myrow * 16 + 8 * hi;
#pragma unroll
        for (int j = 0; j < 8; ++j) { const f32x2 cs = csr[j]; const float x1 = f[4][j], x2 = f[5][j]; f[4][j] = x1 * cs.x - x2 * cs.y; f[5][j] = x2 * cs.x + x1 * cs.y; }
        float n2 = 0.f;
#pragma unroll
        for (int d0 = 0; d0 < 6; ++d0)
#pragma unroll
            for (int j = 0; j < 8; ++j) n2 += f[d0][j] * f[d0][j];
        n2 = swap_sum(n2);
        float gm_ = fabsf(a.k_head_g[lane]); if (lane < 32) gm_ = fmaxf(gm_, fabsf(a.k_head_g[64 + lane])); gm_ = wave_max(gm_);
        const float Mq = __builtin_sqrtf(n2) * gm_ * (9.797959f * 1.02f) * C2;
#pragma unroll
        for (int d0 = 0; d0 < 6; ++d0) { v4u w;
#pragma unroll
            for (int i = 0; i < 4; ++i) w[i] = pk2(f[d0][2 * i] * C2, f[d0][2 * i + 1] * C2);
            qr[d0] = __builtin_bit_cast(bf16x8, w); }
#pragma unroll
        for (int r = 0; r < 16; ++r) negm[r] = -Mq;
    }
    VM_WAIT();
    __builtin_amdgcn_sched_barrier(0);
    const bf16* ksrc = KF + (rowbase + lane) * 768 + h * 96 + 8 * wid;
    const bf16* vsrc = VF + (rowbase + 16 * (wid & 3) + (lane >> 2)) * 512 + h * 64 + (wid >> 2) * 32 + (lane & 3) * 8;
    const unsigned kdst = lds0 + L_K + wid * 1024, vdst = lds0 + L_V + wid * 1024;
#define DMA_TILE(t, sl) do { const bf16* ks_ = ksrc + (long)(t) * 64 * 768; \
        glds16(ks_, (unsigned)__builtin_amdgcn_readfirstlane(kdst + (sl) * KSLOT)); \
        if (wid < 4) glds16(ks_ + 64, (unsigned)__builtin_amdgcn_readfirstlane(kdst + (sl) * KSLOT + 8192)); \
        glds16(vsrc + (long)(t) * 64 * 512, (unsigned)__builtin_amdgcn_readfirstlane(vdst + (sl) * VSLOT)); } while (0)
    DMA_TILE(0, 0); DMA_TILE(1, 1);
    float lsum = 0.f; f32x16 o0 = {}, o1 = {};
    const LAS char* kp0 = (const LAS char*)shm3 + L_K + hi * 1024 + r32 * 16;
    const LAS char* vp0 = (const LAS char*)shm3 + L_V + ((lane >> 4) & 1) * 32 + (lane & 3) * 8 + (4 * hi + ((lane & 15) >> 2)) * 64;
    int slot = 0;
    for (int j = 0; j < NT; ++j) {
        if (j + 1 < NT) { if (wid < 4) asm volatile("s_waitcnt vmcnt(3)" ::: "memory"); else asm volatile("s_waitcnt vmcnt(2)" ::: "memory"); }
        else asm volatile("s_waitcnt vmcnt(0)" ::: "memory");
        asm volatile("s_waitcnt lgkmcnt(0)\n\ts_barrier" ::: "memory");
        if (j + 2 < NT) { const int s2 = (slot >= 1) ? slot - 1 : 2; DMA_TILE(j + 2, s2); }
        if (j < my_nt) {
            const LAS char* kp = kp0 + slot * KSLOT;
            f32x16 p0 = negm, p1 = negm;
#pragma unroll
            for (int d0 = 0; d0 < 6; ++d0) {
                const bf16x8 k0 = *(const LAS bf16x8*)(kp + d0 * 2048), k1 = *(const LAS bf16x8*)(kp + d0 * 2048 + 512);
                p0 = __builtin_amdgcn_mfma_f32_32x32x16_bf16(k0, qr[d0], p0, 0, 0, 0);
                p1 = __builtin_amdgcn_mfma_f32_32x32x16_bf16(k1, qr[d0], p1, 0, 0, 0);
            }
            float sacc = 0.f;
#pragma unroll
            for (int r = 0; r < 16; ++r) { p0[r] = fast_exp2(p0[r]); p1[r] = fast_exp2(p1[r]); sacc += p0[r] + p1[r]; }
            lsum += sacc;
            v4u pw[4];
#pragma unroll
            for (int i = 0; i < 4; ++i) { pw[0][i] = pk2(p0[2 * i], p0[2 * i + 1]); pw[1][i] = pk2(p0[8 + 2 * i], p0[9 + 2 * i]); pw[2][i] = pk2(p1[2 * i], p1[2 * i + 1]); pw[3][i] = pk2(p1[8 + 2 * i], p1[9 + 2 * i]); }
            const LAS char* vp = vp0 + slot * VSLOT;
#pragma unroll
            for (int ks = 0; ks < 4; ++ks) {
                const s16x4 l0 = vtr(vp + ks * 1024), h0 = vtr(vp + ks * 1024 + 512), l1 = vtr(vp + 4096 + ks * 1024), h1 = vtr(vp + 4096 + ks * 1024 + 512);
                const bf16x8 v0 = (bf16x8){l0[0], l0[1], l0[2], l0[3], h0[0], h0[1], h0[2], h0[3]}, v1 = (bf16x8){l1[0], l1[1], l1[2], l1[3], h1[0], h1[1], h1[2], h1[3]};
                const bf16x8 pa = __builtin_bit_cast(bf16x8, pw[ks]);
                o0 = __builtin_amdgcn_mfma_f32_32x32x16_bf16(pa, v0, o0, 0, 0, 0);
                o1 = __builtin_amdgcn_mfma_f32_32x32x16_bf16(pa, v1, o1, 0, 0, 0);
            }
        }
        slot = (slot == 2) ? 0 : slot + 1;
    }
#undef DMA_TILE
    lsum = swap_sum(lsum);
    LAS float* wsf = (LAS float*)(shm3 + L_WS) + wid * 64;
    if (hi == 0) wsf[r32] = lsum;
    LDS_WAIT();
    LAS bf16* stg = (LAS bf16*)(shm3 + L_OST) + wid * 2048;
#pragma unroll
    for (int r = 0; r < 16; ++r) { const int orow = crow(r, hi); const float rl = __builtin_amdgcn_rcpf(wsf[orow]);
        stg[orow * 64 + r32] = (bf16)(pk2(o0[r] * rl, 0.f) & 0xffffu); stg[orow * 64 + 32 + r32] = (bf16)(pk2(o1[r] * rl, 0.f) & 0xffffu); }
    LDS_WAIT();
    bf16* Ow = AO + (rowbase + q0 + wid * 32) * 512 + h * 64;
#pragma unroll
    for (int i = 0; i < 4; ++i) { const int row = i * 8 + (lane >> 3), ch = lane & 7; const v4u v = *(const LAS v4u*)(stg + row * 64 + ch * 8); *(v4u*)(Ow + (long)row * 512 + ch * 8) = v; }
    asm volatile("s_waitcnt lgkmcnt(0)\n\ts_barrier" ::: "memory");
}
}

__device__ __forceinline__ void p5_attn_norm(const Args& a, int vcu, int G, int wave, int lane) {
    const bf16* AO = (const bf16*)(a.ws + WS_AO); bf16* MIX = (bf16*)(a.ws + WS_MIX);
    const int c0 = 8 * lane; float g[8];
#pragma unroll
    for (int i = 0; i < 8; ++i) g[i] = a.attn_out_g[c0 + i];
    const int gw = vcu * 8 + wave, NGW = G * 8;
    for (int row = gw; row < T; row += NGW) {
        const v4u w = *(const v4u*)(AO + (size_t)row * 512 + c0);
        float f[8]; float ss = 0.f;
#pragma unroll
        for (int i = 0; i < 4; ++i) { f[2 * i] = bflo(w[i]); f[2 * i + 1] = bfhi(w[i]); ss += f[2 * i] * f[2 * i] + f[2 * i + 1] * f[2 * i + 1]; }
        const float r = __builtin_amdgcn_rsqf(wave_sum(ss) * (1.f / AW) + EPS);
        v4u o;
#pragma unroll
        for (int i = 0; i < 4; ++i) o[i] = pk2(f[2 * i] * r * g[2 * i], f[2 * i + 1] * r * g[2 * i + 1]);
        *(v4u*)(MIX + (size_t)row * 1024 + c0) = o;
    }
}

__device__ __forceinline__ void p7_router(const Args& a, LAS unsigned char* lds, int vcu, int G, int wave, int lane, int tid) {
    unsigned char* ws = a.ws;
    for (int i = tid; i < 8192; i += 512) ((LAS v4u*)lds)[i] = ((const v4u*)(ws + WS_RT))[i];
    LAS int* LCNT = (LAS int*)(lds + LCNT_OFF); LAS int* LBASE = (LAS int*)(lds + LBASE_OFF);
    gu32* gcnt = (gu32*)(ws + WS_CTL) + CW_CNT;
    int* POS = (int*)(ws + WS_POS); float* GWt = (float*)(ws + WS_GW); int* TOKL = (int*)(ws + WS_TOKL); float* RSL = (float*)(ws + WS_RSL);
    const int fr = lane & 15, kq = lane >> 4;
    for (int rnd = vcu; rnd < T / 128; rnd += G) {
        if (tid < 32) LCNT[tid] = 0;
        __syncthreads();
        const int t = rnd * 128 + wave * 16 + fr;
        const float* xr = a.out + (size_t)t * D + 8 * kq;
        f32x4 d0 = {0.f, 0.f, 0.f, 0.f}, d1 = {0.f, 0.f, 0.f, 0.f}; float ss = 0.f;
        const LAS char* rp = (const LAS char*)lds + (kq * 32 + fr) * 16;
#pragma unroll 4
        for (int s = 0; s < 32; ++s) {
            const f32x4 xa = *(const f32x4*)(xr + 32 * s), xb = *(const f32x4*)(xr + 32 * s + 4);
            ss += (xa[0] * xa[0] + xa[1] * xa[1]) + (xa[2] * xa[2] + xa[3] * xa[3]) + (xb[0] * xb[0] + xb[1] * xb[1]) + (xb[2] * xb[2] + xb[3] * xb[3]);
            v4u hw, lw;
            hw[0] = pk2(xa[0], xa[1]); hw[1] = pk2(xa[2], xa[3]); hw[2] = pk2(xb[0], xb[1]); hw[3] = pk2(xb[2], xb[3]);
            lw[0] = pk2(xa[0] - bflo(hw[0]), xa[1] - bfhi(hw[0])); lw[1] = pk2(xa[2] - bflo(hw[1]), xa[3] - bfhi(hw[1]));
            lw[2] = pk2(xb[0] - bflo(hw[2]), xb[1] - bfhi(hw[2])); lw[3] = pk2(xb[2] - bflo(hw[3]), xb[3] - bfhi(hw[3]));
            const bf16x8 xh = __builtin_bit_cast(bf16x8, hw), xl = __builtin_bit_cast(bf16x8, lw);
            const bf16x8 rh0 = *(const LAS bf16x8*)(rp + s * 2048), rh1 = *(const LAS bf16x8*)(rp + s * 2048 + 256);
            const bf16x8 rl0 = *(const LAS bf16x8*)(rp + 65536 + s * 2048), rl1 = *(const LAS bf16x8*)(rp + 65536 + s * 2048 + 256);
            d0 = __builtin_amdgcn_mfma_f32_16x16x32_bf16(rh0, xh, d0, 0, 0, 0); d1 = __builtin_amdgcn_mfma_f32_16x16x32_bf16(rh1, xh, d1, 0, 0, 0);
            d0 = __builtin_amdgcn_mfma_f32_16x16x32_bf16(rl0, xh, d0, 0, 0, 0); d1 = __builtin_amdgcn_mfma_f32_16x16x32_bf16(rl1, xh, d1, 0, 0, 0);
            d0 = __builtin_amdgcn_mfma_f32_16x16x32_bf16(rh0, xl, d0, 0, 0, 0); d1 = __builtin_amdgcn_mfma_f32_16x16x32_bf16(rh1, xl, d1, 0, 0, 0);
        }
        ss += __shfl_xor(ss, 16); ss += __shfl_xor(ss, 32);
        const float rstd = __builtin_amdgcn_rsqf(ss * (1.f / D) + EPS);
        float lg[32];
#pragma unroll
        for (int q = 0; q < 4; ++q)
#pragma unroll
            for (int r = 0; r < 4; ++r) { lg[4 * q + r] = __shfl(d0[r], fr + 16 * q) * rstd + a.router_b[4 * q + r]; lg[16 + 4 * q + r] = __shfl(d1[r], fr + 16 * q) * rstd + a.router_b[16 + 4 * q + r]; }
        unsigned taken = 0u; float tv[4]; int ti[4];
#pragma unroll
        for (int k = 0; k < 4; ++k) { float best = -INFINITY; int bi = 0;
#pragma unroll
            for (int e = 0; e < 32; ++e) { const bool ok = !((taken >> e) & 1u) && (lg[e] > best); best = ok ? lg[e] : best; bi = ok ? e : bi; }
            tv[k] = best; ti[k] = bi; taken |= 1u << bi; }
        float ex[4], es = 0.f;
#pragma unroll
        for (int k = 0; k < 4; ++k) { ex[k] = __expf(tv[k] - tv[0]); es += ex[k]; }
        const float ies = 1.f / es;
        int rank[4];
        if (kq == 0) {
#pragma unroll
            for (int k = 0; k < 4; ++k) rank[k] = __hip_atomic_fetch_add(LCNT + ti[k], 1, __ATOMIC_RELAXED, __HIP_MEMORY_SCOPE_WORKGROUP);
        }
        __syncthreads();
        if (tid < 32) { const int c = LCNT[tid]; int base = 0; if (c > 0) base = (int)__hip_atomic_fetch_add(gcnt + 64 * tid, (unsigned)c, __ATOMIC_RELAXED, __HIP_MEMORY_SCOPE_AGENT); LBASE[tid] = base; }
        __syncthreads();
        if (kq == 0) {
#pragma unroll
            for (int k = 0; k < 4; ++k) { const int e = ti[k]; const int sl = LBASE[e] + rank[k];
                TOKL[(size_t)e * T + sl] = t; RSL[(size_t)e * T + sl] = rstd; POS[t * 4 + k] = (e << 16) | sl; GWt[t * 4 + k] = ex[k] * ies; }
        }
        __syncthreads();
    }
}

__device__ __forceinline__ void moe_tables(const Args& a, LAS unsigned char* lds, int tid) {
    LAS int* TS = (LAS int*)(lds + TS_OFF); LAS int* EC = (LAS int*)(lds + ECNT_OFF);
    const gu32* gcnt = (const gu32*)(a.ws + WS_CTL) + CW_CNT;
    if (tid == 0) { int acc = 0; for (int e = 0; e < NE; ++e) { const int c = (int)__hip_atomic_load(gcnt + 64 * e, __ATOMIC_RELAXED, __HIP_MEMORY_SCOPE_AGENT); EC[e] = c; TS[e] = acc; acc += (c + 255) >> 8; } TS[NE] = acc; }
    __syncthreads();
}

__device__ __forceinline__ void p10_combine(const Args& a, LAS unsigned char* lds, int vcu, int G, int wave, int lane) {
    const LAS int* TS = (const LAS int*)(lds + TS_OFF);
    const int* POS = (const int*)(a.ws + WS_POS); const float* GWt = (const float*)(a.ws + WS_GW); const bf16* YS = (const bf16*)(a.ws + WS_YS);
    const int gw = vcu * 8 + wave, NGW = G * 8;
    for (int t = gw; t < T; t += NGW) {
        float* orow = a.out + (size_t)t * D;
        f32x4 v[2][2];
#pragma unroll
        for (int j = 0; j < 2; ++j) { v[j][0] = *(const f32x4*)(orow + 512 * j + 8 * lane); v[j][1] = *(const f32x4*)(orow + 512 * j + 8 * lane + 4); }
#pragma unroll
        for (int k = 0; k < 4; ++k) { const int p = POS[t * 4 + k]; const float w = GWt[t * 4 + k]; const int e = p >> 16, sl = p & 0xffff;
            const bf16* yr = YS + ((size_t)TS[e] * 256 + sl) * 1024;
#pragma unroll
            for (int j = 0; j < 2; ++j) { const v4u y = *(const v4u*)(yr + 512 * j + 8 * lane);
                v[j][0][0] += w * bflo(y[0]); v[j][0][1] += w * bfhi(y[0]); v[j][0][2] += w * bflo(y[1]); v[j][0][3] += w * bfhi(y[1]);
                v[j][1][0] += w * bflo(y[2]); v[j][1][1] += w * bfhi(y[2]); v[j][1][2] += w * bflo(y[3]); v[j][1][3] += w * bfhi(y[3]); } }
#pragma unroll
        for (int j = 0; j < 2; ++j) { *(f32x4*)(orow + 512 * j + 8 * lane) = v[j][0]; *(f32x4*)(orow + 512 * j + 8 * lane + 4) = v[j][1]; }
    }
}

__global__ void __launch_bounds__(512, 2) mk_fwd(Args args) {
    extern __shared__ __attribute__((aligned(16))) unsigned char lds_raw[];
    LAS unsigned char* lds = (LAS unsigned char*)lds_raw;
    const int tid = threadIdx.x, lane = tid & 63, wave = __builtin_amdgcn_readfirstlane(tid >> 6);
    const int G = gridDim.x; const int bx = blockIdx.x; const int vcu = (G % 8 == 0) ? (bx % 8) * (G / 8) + bx / 8 : bx;
    unsigned char* ws = args.ws;
    for (int u = tid; u < (LDS_BYTES - MISC_OFF) / 4; u += 512) ((LAS unsigned*)(lds + MISC_OFF))[u] = 0u;
    __syncthreads();
    gu32* ctl = (gu32*)(ws + WS_CTL);
#if MK_PER_PHASE
#define GRID_BAR() do { } while (0)
#else
    XcdBarrier bar = xcd_barrier_post((unsigned*)ctl + CW_BAR + args.li * XCD_BAR_WORDS, (volatile LAS unsigned*)(lds + MISC_OFF));
#define GRID_BAR() xcd_barrier(bar)
#endif
    const int lo = args.ph_lo, hi = args.ph_hi;
#define IN(k) (lo <= (k) && (k) < hi)
#define BOTH(k) (IN(k) && IN((k) + 1))

    if (IN(0)) { p0_prologue(args, lds, vcu, G, wave, lane, tid); if (BOTH(0)) GRID_BAR(); }

    if (IN(1)) {
        gm::DenseSched Sd; Sd.init(ws + WS_H1, ws + WS_WIN, T, NIN1, 1024, 1024, G, bx);
        gm::EpiIn E{(bf16*)(ws + WS_CQKV), (bf16*)(ws + WS_Y), (float*)(ws + WS_KPE)};
        gm::gemm_phase<false>(lds, Sd, E);
        if (BOTH(1)) GRID_BAR();
    }
    if (IN(2)) { p2_thin(args, lds, vcu, G, wave, lane, tid); if (BOTH(2)) GRID_BAR(); }

    if (IN(3)) {
        { gm::DenseSched Sd; Sd.init(ws + WS_CQKV, ws + WS_WUQ, T, 768, QL, 512, G, bx);
          gm::EpiPlain E{(bf16*)(ws + WS_QRAW), 768};
          gm::gemm_phase<false>(lds, Sd, E); }
        { gm::DenseSched Sd; Sd.init(ws + WS_CQKV + QL * 2, ws + WS_WUKV, T, 1024, KVL, 512, G, bx);
          gm::EpiKV E{(bf16*)(ws + WS_KF), (bf16*)(ws + WS_VF), (const float*)(ws + WS_RSKV), (const float*)(ws + WS_KSS), (const float*)(ws + WS_KR), args.k_head_g};
          gm::gemm_phase<false>(lds, Sd, E); }
        if (BOTH(3)) GRID_BAR();
    }
    if (IN(4)) {
        for (int v = vcu; v < 256; v += G) {
            const int bh = v >> 2, j = v & 3;
            for (int i = 0; i < 4; ++i) { const int qb = (i == 0) ? j : (i == 1) ? 15 - j : (i == 2) ? 4 + j : 11 - j; at::attn_unit(args, bh >> 3, bh & 7, qb, lds); }
        }
        if (BOTH(4)) GRID_BAR();
    }
    if (IN(5)) { p5_attn_norm(args, vcu, G, wave, lane); if (BOTH(5)) GRID_BAR(); }

    if (IN(6)) {
        gm::DenseSched Sd; Sd.init(ws + WS_MIX, ws + WS_WOUT, T, 1024, 1024, 1024, G, bx);
        gm::EpiX1 E{args.x, args.out, ws + WS_X1Q};
        gm::gemm_phase<false>(lds, Sd, E);
        if (BOTH(6)) GRID_BAR();
    }
    if (IN(7)) { p7_router(args, lds, vcu, G, wave, lane, tid); if (BOTH(7)) GRID_BAR(); }

    if (IN(8) || IN(9) || IN(10)) moe_tables(args, lds, tid);
    const int ngrp = (G % 8 == 0) ? 8 : 1, cpg = G / ngrp, epg = NE / ngrp;
    if (IN(8)) {
        gm::MoeSched<true> Sm{(const char*)(ws + WS_X1Q), (const char*)(ws + WS_WGU8), 512, 512, 2048, 8, (const int*)(ws + WS_TOKL), (const LAS int*)(lds + TS_OFF), (const LAS int*)(lds + ECNT_OFF), vcu / cpg, vcu % cpg, cpg, epg};
        gm::EpiGU E{ws + WS_ACT8, args.b_gate_up, (const float*)(ws + WS_RSL), (const LAS int*)(lds + ECNT_OFF)};
        gm::gemm_phase<true>(lds, Sm, E);
        if (BOTH(8)) GRID_BAR();
    }
    if (IN(9)) {
        gm::MoeSched<false> Sm{(const char*)(ws + WS_ACT8), (const char*)(ws + WS_WD8), 512, 512, 1024, 4, nullptr, (const LAS int*)(lds + TS_OFF), (const LAS int*)(lds + ECNT_OFF), vcu / cpg, vcu % cpg, cpg, epg};
        gm::EpiDown E{(bf16*)(ws + WS_YS), args.b_down};
        gm::gemm_phase<true>(lds, Sm, E);
        if (BOTH(9)) GRID_BAR();
    }
    if (IN(10)) { p10_combine(args, lds, vcu, G, wave, lane); }
#undef IN
#undef BOTH
}

extern "C" void kernel_launch(void* const* d_in, const int* in_sizes, int n_in, void* d_out, int out_size, void* d_ws, size_t ws_size, hipStream_t stream) {
    static int grid = 0;
    if (grid == 0) {
        if (n_in != 24 || in_sizes[0] != T * D || out_size != T * D || ws_size < WS_END) { fprintf(stderr, "kernel_launch: unexpected shapes (n_in %d, in0 %d, out %d, ws %zu < %zu)\n", n_in, n_in > 0 ? in_sizes[0] : -1, out_size, ws_size, (size_t)WS_END); grid = -1; return; }
        int dev = 0, cus = 0, per_cu = 0;
        if (hipGetDevice(&dev) != hipSuccess || hipDeviceGetAttribute(&cus, hipDeviceAttributeMultiprocessorCount, dev) != hipSuccess) { fprintf(stderr, "kernel_launch: device query failed\n"); grid = -1; return; }
        if (hipFuncSetAttribute((const void*)mk_fwd, hipFuncAttributeMaxDynamicSharedMemorySize, LDS_BYTES) != hipSuccess) { fprintf(stderr, "kernel_launch: hipFuncSetAttribute failed\n"); grid = -1; return; }
        if (hipOccupancyMaxActiveBlocksPerMultiprocessor(&per_cu, (const void*)mk_fwd, 512, LDS_BYTES) != hipSuccess || per_cu < 1) fprintf(stderr, "kernel_launch: occupancy query says %d\n", per_cu);
        (void)hipGetLastError();
        grid = cus;
    }
    if (grid < 0) return;
    if (hipMemsetAsync((char*)d_ws + WS_CTL, 0, CTL_ZERO_BYTES, stream) != hipSuccess) { fprintf(stderr, "kernel_launch: memset failed\n"); return; }
    Args a{};
    a.x = (const float*)d_in[0]; a.positions = (const int*)d_in[1]; a.norm_mix_g = (const float*)d_in[2]; a.w_in = (const float*)d_in[3]; a.q_latent_g = (const float*)d_in[4]; a.w_uq = (const float*)d_in[5];
    a.kv_latent_g = (const float*)d_in[6]; a.w_ukv = (const float*)d_in[7]; a.q_head_g = (const float*)d_in[8]; a.k_head_g = (const float*)d_in[9]; a.conv_dw_w = (const float*)d_in[10]; a.conv_dw_b = (const float*)d_in[11];
    a.conv_ln_g = (const float*)d_in[12]; a.conv_ln_b = (const float*)d_in[13]; a.attn_out_g = (const float*)d_in[14]; a.conv_out_g = (const float*)d_in[15]; a.w_out = (const float*)d_in[16]; a.norm_ffn_g = (const float*)d_in[17];
    a.router_w = (const float*)d_in[18]; a.router_b = (const float*)d_in[19]; a.w_gate_up = (const float*)d_in[20]; a.b_gate_up = (const float*)d_in[21]; a.w_down = (const float*)d_in[22]; a.b_down = (const float*)d_in[23];
    a.out = (float*)d_out; a.ws = (unsigned char*)d_ws;
#if MK_PER_PHASE
    for (int p = 0; p < NPH; ++p) { a.ph_lo = p; a.ph_hi = p + 1; hipLaunchKernelGGL(mk_fwd, dim3(grid), dim3(512), LDS_BYTES, stream, a); }
#elif defined(PROBE_DUP)
    { const int k = PROBE_DUP; const int los[3] = {0, k, k + 1}, his[3] = {k + 1, k + 1, NPH};
      for (int l = 0; l < 3; ++l) { if (los[l] >= his[l]) continue; a.ph_lo = los[l]; a.ph_hi = his[l]; a.li = l; hipLaunchKernelGGL(mk_fwd, dim3(grid), dim3(512), LDS_BYTES, stream, a); } }
#else
    a.ph_lo = 0; a.ph_hi = NPH; hipLaunchKernelGGL(mk_fwd, dim3(grid), dim3(512), LDS_BYTES, stream, a);
#endif
    const hipError_t le = hipPeekAtLastError();
    if (le != hipSuccess) fprintf(stderr, "kernel_launch: launch failed: %s\n", hipGetErrorName(le));
}
```

```cpp
#include <hip/hip_runtime.h>
#include <cstdio>
#include <cstdint>

#ifndef MK_PER_PHASE
#define MK_PER_PHASE 0
#endif

#define GAS __attribute__((address_space(1)))
#define LAS __attribute__((address_space(3)))
typedef unsigned short bf16;
typedef unsigned v4u __attribute__((ext_vector_type(4)));
typedef unsigned v2u __attribute__((ext_vector_type(2)));
typedef float f32x4 __attribute__((ext_vector_type(4)));
typedef float f32x2 __attribute__((ext_vector_type(2)));
typedef float f32x16 __attribute__((ext_vector_type(16)));
typedef short bf16x8 __attribute__((ext_vector_type(8)));
typedef short s16x4 __attribute__((ext_vector_type(4)));
typedef int v4i_t __attribute__((ext_vector_type(4)));
typedef int v8i_t __attribute__((ext_vector_type(8)));
typedef __bf16 bf16x2_t __attribute__((ext_vector_type(2)));
typedef GAS unsigned gu32;

constexpr int NB = 8, S = 4096, T = NB * S, D = 1024;
constexpr int NH = 8, DQK = 96, DV = 64;
constexpr int QL = 384, KVL = 128, CW = 512, AW = 512, CK = 31, INW = 1568;
constexpr int NE = 32, DFF = 1024;
constexpr float EPS = 1e-6f;
constexpr int NIN1 = 1792;
constexpr int MAXSLOT = T * 4 + NE * 256;
constexpr float C2 = 0.14724445f;
constexpr int NPH = 11;

constexpr size_t MiB = 1u << 20;
constexpr size_t WS_CTL = 0, CTL_ZERO_BYTES = 1 * MiB;
constexpr size_t WS_WIN = 2 * MiB, WS_WUQ = 6 * MiB, WS_WUKV = 7 * MiB, WS_WOUT = 8 * MiB, WS_RT = 10 * MiB, WS_CS = 12 * MiB;
constexpr size_t WS_RSQ = 16 * MiB, WS_RSKV = WS_RSQ + 128 * 1024, WS_KSS = WS_RSKV + 128 * 1024;
constexpr size_t WS_KR = 17 * MiB, WS_POS = 21 * MiB, WS_GW = WS_POS + 512 * 1024, WS_TOKL = 22 * MiB, WS_RSL = 26 * MiB;
constexpr size_t WS_WGU8 = 32 * MiB, WS_WD8 = 96 * MiB;
constexpr size_t WS_H1 = 128 * MiB, WS_CQKV = 192 * MiB, WS_Y = 224 * MiB, WS_KPE = 256 * MiB;
constexpr size_t WS_QRAW = 260 * MiB, WS_KF = 308 * MiB, WS_VF = 356 * MiB, WS_AO = 388 * MiB, WS_MIX = 420 * MiB, WS_X1Q = 484 * MiB, WS_ACT8 = 516 * MiB;
constexpr size_t WS_YS = 128 * MiB;
constexpr size_t WS_END = 652 * MiB;
static_assert(WS_ACT8 + (size_t)MAXSLOT * 1024 <= WS_END && WS_YS + (size_t)MAXSLOT * 1024 * 2 <= WS_MIX, "ws map");
constexpr int CW_TMO = 0, CW_BAR = 4096, CW_CNT = 32768;

constexpr int RING_BYTES = 131072;
constexpr int MISC_OFF = RING_BYTES;
constexpr int LCNT_OFF = MISC_OFF + 64;
constexpr int LBASE_OFF = LCNT_OFF + 128;
constexpr int TS_OFF = LBASE_OFF + 128;
constexpr int ECNT_OFF = TS_OFF + 160;
constexpr int LDS_BYTES = 147456;

#define LDS_WAIT() asm volatile("s_waitcnt lgkmcnt(0)" ::: "memory")
#define VM_WAIT() asm volatile("s_waitcnt vmcnt(0)" ::: "memory")

__device__ __forceinline__ unsigned pk2(float lo, float hi) { f32x2 v = {lo, hi}; bf16x2_t b = __builtin_convertvector(v, bf16x2_t); return __builtin_bit_cast(unsigned, b); }
__device__ __forceinline__ float clamp448(float v) { return __builtin_fminf(__builtin_fmaxf(v, -448.f), 448.f); }
__device__ __forceinline__ v2u pack8_fp8(float a0, float a1, float a2, float a3, float a4, float a5, float a6, float a7) {
    int w0 = 0, w1 = 0;
    w0 = __builtin_amdgcn_cvt_pk_fp8_f32(clamp448(a0), clamp448(a1), w0, false); w0 = __builtin_amdgcn_cvt_pk_fp8_f32(clamp448(a2), clamp448(a3), w0, true);
    w1 = __builtin_amdgcn_cvt_pk_fp8_f32(clamp448(a4), clamp448(a5), w1, false); w1 = __builtin_amdgcn_cvt_pk_fp8_f32(clamp448(a6), clamp448(a7), w1, true);
    return (v2u){(unsigned)w0, (unsigned)w1};
}
__device__ __forceinline__ float bflo(unsigned w) { return __builtin_bit_cast(float, w << 16); }
__device__ __forceinline__ float bfhi(unsigned w) { return __builtin_bit_cast(float, w & 0xffff0000u); }
__device__ __forceinline__ float wave_sum(float v) {
#pragma unroll
    for (int o = 1; o < 64; o <<= 1) v += __shfl_xor(v, o);
    return v;
}
__device__ __forceinline__ float wave_max(float v) {
#pragma unroll
    for (int o = 1; o < 64; o <<= 1) v = fmaxf(v, __shfl_xor(v, o));
    return v;
}
__device__ __forceinline__ float swap_sum(float v) { auto rr = __builtin_amdgcn_permlane32_swap(__float_as_uint(v), __float_as_uint(v), false, false); return __uint_as_float(rr[0]) + __uint_as_float(rr[1]); }
__device__ __forceinline__ float fast_exp2(float x) { return __builtin_amdgcn_exp2f(x); }
__device__ __forceinline__ float sigmoidf_(float g) { return __builtin_amdgcn_rcpf(1.f + fast_exp2(-1.4426950408889634f * g)); }

#define XB_TMO      128
#define XB_XCNT(j)  (256  + 64 * (j))
#define XB_XSUB(j)  (1280 + 64 * (j))
#define XB_XGEN(j)  (2304 + 64 * (j))
#define XB_TOP      3328
#define XB_TOPGEN   3392
#define XCD_BAR_WORDS 3456
#define XB_SPIN_CAP (1u << 18)
__device__ __forceinline__ unsigned xb_ld(unsigned* p)              { return __hip_atomic_load(p, __ATOMIC_RELAXED, __HIP_MEMORY_SCOPE_AGENT); }
__device__ __forceinline__ unsigned xb_add(unsigned* p, unsigned v) { return __hip_atomic_fetch_add(p, v, __ATOMIC_RELAXED, __HIP_MEMORY_SCOPE_AGENT); }
__device__ __forceinline__ unsigned xb_xcc_id() { return (unsigned)__builtin_amdgcn_s_getreg((3 << 11) | 20) & 0xFu; }
#define XB_SPIN(cond, bar) do { unsigned _sp = 0; while (cond) { __builtin_amdgcn_s_sleep(1); \
    if ((++_sp & 255u) == 0u) { if (xb_ld(&(bar)[XB_TMO])) break; if (_sp > XB_SPIN_CAP) { atomicAdd(&(bar)[XB_TMO], 1u); break; } } } } while (0)
struct XcdBarrier { unsigned* bar; unsigned x; volatile LAS unsigned* st; };
__device__ __forceinline__ XcdBarrier xcd_barrier_post(unsigned* bar, volatile LAS unsigned* st) {
    XcdBarrier b; b.bar = bar; b.x = xb_xcc_id(); b.st = st;
    if (threadIdx.x == 0) (void)xb_add(&bar[XB_XCNT(b.x)], 1u);
    return b;
}
__device__ __forceinline__ void xcd_barrier_complete(unsigned* bar, unsigned x, unsigned& nloc, unsigned& nx) {
    const unsigned G = gridDim.x * gridDim.y * gridDim.z;
    unsigned sum, cnt, mine, sp = 0u;
    for (;;) {
        sum = 0u; cnt = 0u; mine = 0u;
#pragma unroll
        for (unsigned j = 0; j < 16; ++j) { const unsigned c = xb_ld(&bar[XB_XCNT(j)]); sum += c; cnt += (c > 0u) ? 1u : 0u; mine = (j == x) ? c : mine; }
        if (sum == G) break;
        __builtin_amdgcn_s_sleep(1);
        if ((++sp & 255u) == 0u) { if (xb_ld(&bar[XB_TMO])) break; if (sp > XB_SPIN_CAP) { atomicAdd(&bar[XB_TMO], 1u); break; } }
    }
    nloc = mine > 0u ? mine : 1u; nx = cnt > 0u ? cnt : 1u;
}
__device__ __forceinline__ void xcd_barrier(const XcdBarrier& b) {
    asm volatile("s_waitcnt vmcnt(0)" ::: "memory");
    __syncthreads();
    if (threadIdx.x == 0) {
        unsigned* bar = b.bar;
        __builtin_amdgcn_s_waitcnt(0);
        unsigned nloc = b.st[0], nx = b.st[1];
        if (nloc == 0u) { xcd_barrier_complete(bar, b.x, nloc, nx); b.st[0] = nloc; b.st[1] = nx; }
        const unsigned old = xb_add(&bar[XB_XSUB(b.x)], 1u);
        const unsigned gen = old / nloc;
        if (old + 1u == (gen + 1u) * nloc) {
            __builtin_amdgcn_fence(__ATOMIC_RELEASE, "agent");
            asm volatile("s_waitcnt vmcnt(0)" ::: "memory");
            const unsigned og = xb_add(&bar[XB_TOP], 1u);
            const unsigned tg = og / nx;
            if (og + 1u == (tg + 1u) * nx) xb_add(&bar[XB_TOPGEN], 1u);
            else XB_SPIN(xb_ld(&bar[XB_TOPGEN]) == tg, bar);
            __builtin_amdgcn_fence(__ATOMIC_ACQUIRE, "agent");
            xb_add(&bar[XB_XGEN(b.x)], 1u);
            asm volatile("s_waitcnt vmcnt(0)" ::: "memory");
        } else {
            XB_SPIN(xb_ld(&bar[XB_XGEN(b.x)]) == gen, bar);
            __builtin_amdgcn_fence(__ATOMIC_ACQUIRE, "agent");
            asm volatile("s_waitcnt vmcnt(0)" ::: "memory");
        }
    }
    __syncthreads();
}

namespace gm {
constexpr int BM = 256, BK = 64, HALF = 128, HTB = HALF * BK * 2, NXCD = 8, WGM = 8;
__host__ __device__ __forceinline__ int lds_byte(int r, int c) { const int st = (r >> 4) * 2 + (c >> 5), rr = r & 15, cc = c & 31, ob = rr * 64 + cc * 2; return st * 1024 + (ob ^ (((ob >> 9) & 1) << 5)); }
__host__ __device__ __forceinline__ void stage_rc(int b, int& R, int& C) { const int st = b / 1024, sb = b % 1024, swz = sb ^ (((sb >> 9) & 1) << 5); R = (st >> 1) * 16 + swz / 64; C = (st & 1) * 32 + (swz % 64) / 2; }
__host__ __device__ __forceinline__ int perm32(int rho) { const int n = rho >> 4, i = rho & 15; return 8 * (i >> 2) + 4 * n + (i & 3); }

struct Unit { int pm, pn, e, rt; };

struct DenseSched {
    const char* A; const char* Bt; int K, lda;
    int nM, nN, nwg, G, c;
    __device__ __forceinline__ void init(const void* A_, const void* Bt_, int M, int N, int K_, int lda_, int G_, int c_) { A = (const char*)A_; Bt = (const char*)Bt_; K = K_; lda = lda_; nM = M / BM; nN = N / BM; nwg = nM * nN; G = G_; c = c_; }
    __device__ __forceinline__ bool next(int i, Unit& u) const {
        const long L = (long)i * G + c; if (L >= nwg) return false;
        int wgid = (int)L; { const int q = nwg / NXCD, r = nwg % NXCD, xcd = wgid % NXCD, off = wgid / NXCD; wgid = (xcd < r ? xcd * (q + 1) : r * (q + 1) + (xcd - r) * q) + off; }
        const int nig = WGM * nN, gid = wgid / nig, fm = gid * WGM, gsz = (nM - fm) < WGM ? (nM - fm) : WGM;
        u.pm = fm + ((wgid % nig) % gsz); u.pn = (wgid % nig) / gsz; u.e = 0; u.rt = u.pm; return true;
    }
    __device__ __forceinline__ const char* b_tile(const Unit& u) const { return Bt + (size_t)u.pn * BM * K * 2; }
    static constexpr bool GATHER = false;
    __device__ __forceinline__ const char* a_tile(const Unit& u) const { return A + (size_t)u.pm * BM * lda * 2; }
    __device__ __forceinline__ void a_off(const Unit&, const int (&)[2], const int (&)[2], unsigned (&)[2][2]) const {}
};
template <bool GATH> struct MoeSched {
    static constexpr bool GATHER = GATH;
    const char* A; const char* Bt; int K, lda, N;
    int nct;
    const int* tokl;
    const LAS int* TS; const LAS int* EC;
    int ulo, uhi; int fix;
    __device__ __forceinline__ void range(int v, int G) { const long U = (long)TS[NE] * nct; ulo = (int)((U * v) / G); uhi = (int)((U * (v + 1)) / G); }
    __device__ __forceinline__ bool next(int i, Unit& u) const {
        const int idx = ulo + i; if (idx >= uhi) return false;
        const int tile = idx / nct; u.pn = idx - tile * nct; u.pm = tile;
        int e = 0;
        for (int q = 1; q < NE; ++q) e += (__builtin_amdgcn_readfirstlane(TS[q]) <= tile) ? 1 : 0;
        u.e = e; u.rt = tile - __builtin_amdgcn_readfirstlane(TS[e]); return true;
    }
#ifdef PROBE_VAR
    __device__ __forceinline__ const char* b_tile(const Unit& u) const { return fix ? Bt + (size_t)(ulo & 3) * BM * K * 2 : Bt + ((size_t)u.e * N + (size_t)u.pn * BM) * K * 2; }
    __device__ __forceinline__ const char* a_tile(const Unit& u) const { return fix ? A + (size_t)(ulo & 63) * BM * lda * 2 : A + (size_t)u.pm * BM * lda * 2; }
#else
    __device__ __forceinline__ const char* b_tile(const Unit& u) const { return Bt + ((size_t)u.e * N + (size_t)u.pn * BM) * K * 2; }
    __device__ __forceinline__ const char* a_tile(const Unit& u) const { return A + (size_t)u.pm * BM * lda * 2; }
#endif
    __device__ __forceinline__ void a_off(const Unit& u, const int (&R)[2], const int (&C)[2], unsigned (&off)[2][2]) const {
        const int cnt = EC[u.e];
#pragma unroll
        for (int h = 0; h < 2; ++h)
#pragma unroll
            for (int i = 0; i < 2; ++i) { const int sl = u.rt * BM + h * HALF + R[i]; const int tok = (sl < cnt) ? tokl[(size_t)u.e * T + sl] : 0; off[h][i] = (unsigned)(((size_t)tok * lda + C[i]) * 2); }
    }
};

template <bool FP8, class Epi, class Sched>
__device__ __forceinline__ void gemm_phase(LAS unsigned char* lds, const Sched& S, const Epi& E, const int skip_epi = 0) {
    const int tid = threadIdx.x, wid = __builtin_amdgcn_readfirstlane(tid >> 6), lane = tid & 63, wr = wid >> 2, wc = wid & 3, fr = lane & 15, fq = lane >> 4;
#ifdef PROBE_VAR
    const bool PV_NOMMA = (skip_epi & 2) != 0;
#else
    constexpr bool PV_NOMMA = false;
#endif
    const int K = S.K, nt = K / BK;
    int R[2], C[2]; unsigned voffB[2];
#pragma unroll
    for (int i = 0; i < 2; ++i) { stage_rc(tid * 16 + i * 8192, R[i], C[i]); const int Rb = (R[i] & ~31) + perm32(R[i] & 31); voffB[i] = (unsigned)(Rb * K + C[i]) * 2u; }
    const size_t kstep = (size_t)(BK * 2);
    const size_t hstepB = (size_t)HALF * K * 2;
    const unsigned ldsw = (unsigned)wid * 1024u;
    const int aoff = lds_byte(wr * 64 + fr, fq * 8), boff = lds_byte(wc * 32 + fr, fq * 8);
#define G_SA(b, h) (((b) * 2 + (h)) * HTB)
#define G_SB(b, h) ((4 + (b) * 2 + (h)) * HTB)
#define G_STAGE(bufoff, gbase, o0, o1) do { \
        __builtin_amdgcn_global_load_lds((const unsigned*)((const char*)(gbase) + (o0)), (LAS unsigned*)(lds + (bufoff) + ldsw), 16, 0, 0); \
        __builtin_amdgcn_global_load_lds((const unsigned*)((const char*)(gbase) + (o1)), (LAS unsigned*)(lds + (bufoff) + ldsw + 8192), 16, 0, 0); } while (0)
#define G_LDA(dst, b, h) do { _Pragma("unroll") for (int m = 0; m < 4; ++m) _Pragma("unroll") for (int k = 0; k < 2; ++k) dst[m][k] = *(const LAS bf16x8*)(lds + G_SA(b, h) + aoff + m * 2048 + k * 1024); } while (0)
#define G_LDB(dst, b, h) do { _Pragma("unroll") for (int n = 0; n < 2; ++n) _Pragma("unroll") for (int k = 0; k < 2; ++k) dst[n][k] = *(const LAS bf16x8*)(lds + G_SB(b, h) + boff + n * 2048 + k * 1024); } while (0)
#define G_CAT(x) __builtin_shufflevector(__builtin_bit_cast(v4i_t, x[0]), __builtin_bit_cast(v4i_t, x[1]), 0, 1, 2, 3, 4, 5, 6, 7)
#define G_MMA(ai, bj, At, Bt) do { if (PV_NOMMA) break; __builtin_amdgcn_s_setprio(1); \
        if constexpr (FP8) { _Pragma("unroll") for (int m = 0; m < 4; ++m) _Pragma("unroll") for (int n = 0; n < 2; ++n) \
            asm volatile("v_mfma_scale_f32_16x16x128_f8f6f4 %0, %1, %2, %0, %3, %4 op_sel_hi:[0,0,0]" : "+v"(acc[ai][bj][m][n]) : "v"(G_CAT(Bt[n])), "v"(G_CAT(At[m])), "v"(sc_w), "v"(sc_a)); } \
        else { _Pragma("unroll") for (int m = 0; m < 4; ++m) _Pragma("unroll") for (int n = 0; n < 2; ++n) _Pragma("unroll") for (int k = 0; k < 2; ++k) \
            acc[ai][bj][m][n] = __builtin_amdgcn_mfma_f32_16x16x32_bf16(Bt[n][k], At[m][k], acc[ai][bj][m][n], 0, 0, 0); } \
        __builtin_amdgcn_s_setprio(0); } while (0)
#define G_WAIT_V(n) asm volatile("s_waitcnt vmcnt(" #n ")" ::: "memory")
#define G_WAIT_L(n) asm volatile("s_waitcnt lgkmcnt(" #n ")" ::: "memory")
#define G_BAR __builtin_amdgcn_s_barrier()
#define G_SCHED __builtin_amdgcn_sched_barrier(0)
    Unit cur, nxt; int ui = 0;
    if (!S.next(0, cur)) return;
    f32x4 acc[2][2][4][2];
#pragma unroll
    for (int a = 0; a < 2; ++a)
#pragma unroll
        for (int b = 0; b < 2; ++b)
#pragma unroll
            for (int m = 0; m < 4; ++m)
#pragma unroll
                for (int n = 0; n < 2; ++n) acc[a][b][m][n] = (f32x4){0.f, 0.f, 0.f, 0.f};
    bf16x8 At[4][2], B0[2][2], B1[2][2];
    const int sc_w = 0x77777777, sc_a = 0x7f7f7f7f;
    unsigned off[2][2], noff[2][2]; unsigned voffA[2];
    const size_t hstepA = (size_t)HALF * S.lda * 2;
    const char* cA = S.A; const char* nA = S.A;
    if constexpr (Sched::GATHER) { S.a_off(cur, R, C, off); voffA[0] = voffA[1] = 0u; }
    else { cA = S.a_tile(cur); voffA[0] = (unsigned)(R[0] * S.lda + C[0]) * 2u; voffA[1] = (unsigned)(R[1] * S.lda + C[1]) * 2u; off[0][0] = off[0][1] = off[1][0] = off[1][1] = 0u; noff[0][0] = noff[0][1] = noff[1][0] = noff[1][1] = 0u; }
#define G_STAGE_A(bufoff, h, ktb, NX) do { \
        if constexpr (Sched::GATHER) { G_STAGE(bufoff, cA + (ktb), (NX) ? noff[h][0] : off[h][0], (NX) ? noff[h][1] : off[h][1]); } \
        else { G_STAGE(bufoff, ((NX) ? nA : cA) + (h) * hstepA + (ktb), voffA[0], voffA[1]); } } while (0)
    const char* cB = S.b_tile(cur);
    G_STAGE(G_SB(0, 0), cB, voffB[0], voffB[1]); G_STAGE(G_SB(0, 1), cB + hstepB, voffB[0], voffB[1]); G_STAGE_A(G_SA(0, 0), 0, 0, false); G_STAGE_A(G_SA(0, 1), 1, 0, false);
    if (wr == 1) G_BAR;
    G_WAIT_V(2); G_BAR;
    G_STAGE(G_SB(1, 0), cB + kstep, voffB[0], voffB[1]); G_STAGE_A(G_SA(1, 0), 0, kstep, false); G_STAGE(G_SB(1, 1), cB + hstepB + kstep, voffB[0], voffB[1]);
    G_WAIT_V(6); G_BAR;
    for (;;) {
        const bool has_next = S.next(ui + 1, nxt);
        if constexpr (Sched::GATHER) { if (has_next) S.a_off(nxt, R, C, noff); else { noff[0][0] = off[0][0]; noff[0][1] = off[0][1]; noff[1][0] = off[1][0]; noff[1][1] = off[1][1]; } }
        else nA = has_next ? S.a_tile(nxt) : cA;
        const char* nB = has_next ? S.b_tile(nxt) : cB;
        for (int t = 0; t < nt; t += 2) {
            const bool last = (t == nt - 2);
            const size_t k1 = (size_t)(t + 1) * kstep;
            const size_t k2 = last ? 0 : (size_t)(t + 2) * kstep, k3 = k2 + kstep;
            const char* b2 = last ? nB : cB + (size_t)(t + 2) * kstep; const char* b3 = b2 + kstep;
            G_LDB(B0, 0, 0); G_LDB(B1, 0, 1); G_SCHED; G_LDA(At, 0, 0); G_STAGE_A(G_SA(1, 1), 1, k1, false);
            G_WAIT_V(8); G_WAIT_L(0); G_BAR; G_MMA(0, 0, At, B0); G_MMA(0, 1, At, B1); G_BAR; G_SCHED;
            G_LDA(At, 0, 1); G_STAGE(G_SB(0, 0), b2, voffB[0], voffB[1]); G_STAGE(G_SB(0, 1), b2 + hstepB, voffB[0], voffB[1]); G_STAGE_A(G_SA(0, 0), 0, k2, last);
            G_WAIT_V(8); G_WAIT_L(0); G_BAR; G_MMA(1, 0, At, B0); G_MMA(1, 1, At, B1); G_BAR; G_SCHED;
            G_LDB(B0, 1, 0); G_LDB(B1, 1, 1); G_SCHED; G_LDA(At, 1, 0); G_STAGE_A(G_SA(0, 1), 1, k2, last);
            G_WAIT_V(8); G_WAIT_L(0); G_BAR; G_MMA(0, 0, At, B0); G_MMA(0, 1, At, B1); G_BAR; G_SCHED;
            G_LDA(At, 1, 1); G_STAGE(G_SB(1, 0), b3, voffB[0], voffB[1]); G_STAGE(G_SB(1, 1), b3 + hstepB, voffB[0], voffB[1]); G_STAGE_A(G_SA(1, 0), 0, k3, last);
            G_WAIT_V(8); G_WAIT_L(0); G_BAR; G_MMA(1, 0, At, B0); G_MMA(1, 1, At, B1); G_BAR; G_SCHED;
        }
        if (wr == 0) G_BAR;
        if constexpr (FP8) asm volatile("s_nop 15\n\ts_nop 15" ::: "memory");
        { int fr_e = fr, fq_e = fq; asm volatile("" : "+v"(fr_e), "+v"(fq_e));
#ifdef PROBE_VAR
          if (skip_epi & 1) {
#pragma unroll
              for (int a = 0; a < 2; ++a)
#pragma unroll
                  for (int b = 0; b < 2; ++b)
#pragma unroll
                      for (int m = 0; m < 4; ++m)
#pragma unroll
                          for (int n = 0; n < 2; ++n) asm volatile("" :: "v"(acc[a][b][m][n]));
          } else
#endif
          E(acc, cur, wr, wc, fr_e, fq_e); }
        if (!has_next) break;
#pragma unroll
        for (int a = 0; a < 2; ++a)
#pragma unroll
            for (int b = 0; b < 2; ++b)
#pragma unroll
                for (int m = 0; m < 4; ++m)
#pragma unroll
                    for (int n = 0; n < 2; ++n) acc[a][b][m][n] = (f32x4){0.f, 0.f, 0.f, 0.f};
        cur = nxt; cB = nB; ++ui;
        if constexpr (Sched::GATHER) { off[0][0] = noff[0][0]; off[0][1] = noff[0][1]; off[1][0] = noff[1][0]; off[1][1] = noff[1][1]; } else cA = nA;
        if (wr == 1) G_BAR;
    }
    G_WAIT_V(0);
    G_BAR;
#undef G_SA
#undef G_SB
#undef G_STAGE
#undef G_STAGE_A
#undef G_LDA
#undef G_LDB
#undef G_MMA
#undef G_CAT
#undef G_WAIT_V
#undef G_WAIT_L
#undef G_BAR
#undef G_SCHED
}

typedef f32x4 Acc[2][2][4][2];
__device__ __forceinline__ v4u pack8(const f32x4 a, const f32x4 b) { v4u w; w.x = pk2(a[0], a[1]); w.y = pk2(a[2], a[3]); w.z = pk2(b[0], b[1]); w.w = pk2(b[2], b[3]); return w; }

struct EpiPlain {
    bf16* O; int ldc;
    __device__ __forceinline__ void operator()(const Acc& acc, const Unit& u, int wr, int wc, int fr, int fq) const {
        const int row0 = u.pm * BM + wr * 64 + fr, col0 = u.pn * BM + wc * 32 + 8 * fq;
#pragma unroll
        for (int ai = 0; ai < 2; ++ai)
#pragma unroll
            for (int m = 0; m < 4; ++m) { bf16* rowp = O + (size_t)(row0 + ai * HALF + m * 16) * ldc + col0;
#pragma unroll
                for (int bj = 0; bj < 2; ++bj) *(v4u*)(rowp + bj * HALF) = pack8(acc[ai][bj][m][0], acc[ai][bj][m][1]); }
    }
};
struct EpiIn {
    bf16* CQKV; bf16* Y; float* KPE;
    __device__ __forceinline__ void operator()(const Acc& acc, const Unit& u, int wr, int wc, int fr, int fq) const {
        const int row0 = u.pm * BM + wr * 64 + fr;
        if (u.pn < 2) {
#pragma unroll
            for (int ai = 0; ai < 2; ++ai)
#pragma unroll
                for (int m = 0; m < 4; ++m) { bf16* rowp = CQKV + (size_t)(row0 + ai * HALF + m * 16) * 512 + u.pn * BM + wc * 32 + 8 * fq;
#pragma unroll
                    for (int bj = 0; bj < 2; ++bj) *(v4u*)(rowp + bj * HALF) = pack8(acc[ai][bj][m][0], acc[ai][bj][m][1]); }
        } else if (u.pn < 6) {
            const int cb = (u.pn - 2) * 128 + wc * 32 + 8 * fq;
#pragma unroll
            for (int ai = 0; ai < 2; ++ai)
#pragma unroll
                for (int m = 0; m < 4; ++m) {
                    f32x4 y0, y1;
#pragma unroll
                    for (int i = 0; i < 4; ++i) { y0[i] = acc[ai][0][m][0][i] * sigmoidf_(acc[ai][1][m][0][i]); y1[i] = acc[ai][0][m][1][i] * sigmoidf_(acc[ai][1][m][1][i]); }
                    *(v4u*)(Y + (size_t)(row0 + ai * HALF + m * 16) * 512 + cb) = pack8(y0, y1); }
        } else {
            if (wc == 0) {
#pragma unroll
                for (int ai = 0; ai < 2; ++ai)
#pragma unroll
                    for (int m = 0; m < 4; ++m) { float* p = KPE + (size_t)(row0 + ai * HALF + m * 16) * 32 + 8 * fq; *(f32x4*)p = acc[ai][0][m][0]; *(f32x4*)(p + 4) = acc[ai][0][m][1]; }
            }
        }
    }
};
struct EpiKV {
    bf16* KF; bf16* VF; const float* rskv; const float* kss; const float* kr; const float* gk;
    __device__ __forceinline__ void operator()(const Acc& acc, const Unit& u, int wr, int wc, int fr, int fq) const {
        const int row0 = u.pm * BM + wr * 64 + fr; const int head = 2 * u.pn + (wc & 1);
        if (wc < 2) {
#pragma unroll
            for (int ai = 0; ai < 2; ++ai)
#pragma unroll
                for (int m = 0; m < 4; ++m) { const int row = row0 + ai * HALF + m * 16; const float rs = rskv[row];
                    float ss = 0.f;
#pragma unroll
                    for (int bj = 0; bj < 2; ++bj)
#pragma unroll
                        for (int n = 0; n < 2; ++n) { const f32x4 q = acc[ai][bj][m][n]; ss += (q[0] * q[0] + q[1] * q[1]) + (q[2] * q[2] + q[3] * q[3]); }
                    ss += __shfl_xor(ss, 16); ss += __shfl_xor(ss, 32);
                    const float rn = __builtin_amdgcn_rsqf((ss * rs * rs + kss[row]) * (1.f / 96.f) + EPS); const float sc = rs * rn;
                    bf16* kp = KF + (size_t)row * 768 + head * 96;
#pragma unroll
                    for (int bj = 0; bj < 2; ++bj) { const f32x4 g0 = *(const f32x4*)(gk + 32 * bj + 8 * fq), g1 = *(const f32x4*)(gk + 32 * bj + 8 * fq + 4);
                        *(v4u*)(kp + 32 * bj + 8 * fq) = pack8(acc[ai][bj][m][0] * g0 * sc, acc[ai][bj][m][1] * g1 * sc); }
                    const f32x4 r0 = *(const f32x4*)(kr + (size_t)row * 32 + 8 * fq), r1 = *(const f32x4*)(kr + (size_t)row * 32 + 8 * fq + 4);
                    *(v4u*)(kp + 64 + 8 * fq) = pack8(r0 * rn, r1 * rn); asm volatile("" ::: "memory"); }
        } else {
#pragma unroll
            for (int ai = 0; ai < 2; ++ai)
#pragma unroll
                for (int m = 0; m < 4; ++m) { const int row = row0 + ai * HALF + m * 16; const float rs = rskv[row]; bf16* vp = VF + (size_t)row * 512 + head * 64 + 8 * fq;
#pragma unroll
                    for (int bj = 0; bj < 2; ++bj) *(v4u*)(vp + 32 * bj) = pack8(acc[ai][bj][m][0] * rs, acc[ai][bj][m][1] * rs); asm volatile("" ::: "memory"); }
        }
    }
};
struct EpiX1 {
    const float* X; float* OUT; unsigned char* X1Q;
    __device__ __forceinline__ void operator()(const Acc& acc, const Unit& u, int wr, int wc, int fr, int fq) const {
        const int row0 = u.pm * BM + wr * 64 + fr, col0 = u.pn * BM + wc * 32 + 8 * fq;
#pragma unroll
        for (int ai = 0; ai < 2; ++ai)
#pragma unroll
            for (int m = 0; m < 4; ++m) { const size_t o = (size_t)(row0 + ai * HALF + m * 16) * D + col0;
#pragma unroll
                for (int bj = 0; bj < 2; ++bj) { const f32x4 a = acc[ai][bj][m][0] + *(const f32x4*)(X + o + bj * HALF), b = acc[ai][bj][m][1] + *(const f32x4*)(X + o + bj * HALF + 4);
                    *(f32x4*)(OUT + o + bj * HALF) = a; *(f32x4*)(OUT + o + bj * HALF + 4) = b; *(v2u*)(X1Q + o + bj * HALF) = pack8_fp8(a[0], a[1], a[2], a[3], b[0], b[1], b[2], b[3]); } asm volatile("" ::: "memory"); }
    }
};
struct EpiGU {
    unsigned char* ACT; const float* bgu; const float* rsl; const LAS int* EC;
    __device__ __forceinline__ void operator()(const Acc& acc, const Unit& u, int wr, int wc, int fr, int fq) const {
        const int r0 = wr * 64 + fr; const int cb = u.pn * 128 + wc * 32 + 8 * fq; const int cnt = EC[u.e];
        const float* bg = bgu + (size_t)u.e * 2048 + cb;
        const f32x4 bg0 = *(const f32x4*)bg, bg1 = *(const f32x4*)(bg + 4), bu0 = *(const f32x4*)(bg + 1024), bu1 = *(const f32x4*)(bg + 1028);
#pragma unroll
        for (int ai = 0; ai < 2; ++ai)
#pragma unroll
            for (int m = 0; m < 4; ++m) { const int rr = r0 + ai * HALF + m * 16; const int sl = u.rt * BM + rr;
                const float rs = (sl < cnt) ? rsl[(size_t)u.e * T + sl] : 0.f;
                f32x4 o[2];
#pragma unroll
                for (int n = 0; n < 2; ++n) { const f32x4 gb = n ? bg1 : bg0, ub = n ? bu1 : bu0;
#pragma unroll
                    for (int i = 0; i < 4; ++i) { float gt = fminf(acc[ai][0][m][n][i] * rs + gb[i], 7.f); float up = fminf(fmaxf(acc[ai][1][m][n][i] * rs + ub[i], -7.f), 7.f);
                        o[n][i] = (up + 1.f) * gt * sigmoidf_(1.702f * gt); } }
                *(v2u*)(ACT + (size_t)(u.pm * BM + rr) * 1024 + cb) = pack8_fp8(o[0][0], o[0][1], o[0][2], o[0][3], o[1][0], o[1][1], o[1][2], o[1][3]); asm volatile("" ::: "memory"); }
    }
};
struct EpiDown {
    bf16* YS; const float* bd;
    __device__ __forceinline__ void operator()(const Acc& acc, const Unit& u, int wr, int wc, int fr, int fq) const {
        const int row0 = u.pm * BM + wr * 64 + fr, col0 = u.pn * BM + wc * 32 + 8 * fq;
        f32x4 b[2][2];
#pragma unroll
        for (int bj = 0; bj < 2; ++bj) { b[bj][0] = *(const f32x4*)(bd + (size_t)u.e * 1024 + col0 + bj * HALF); b[bj][1] = *(const f32x4*)(bd + (size_t)u.e * 1024 + col0 + bj * HALF + 4); }
#pragma unroll
        for (int ai = 0; ai < 2; ++ai)
#pragma unroll
            for (int m = 0; m < 4; ++m) { bf16* rowp = YS + (size_t)(row0 + ai * HALF + m * 16) * 1024 + col0;
#pragma unroll
                for (int bj = 0; bj < 2; ++bj) *(v4u*)(rowp + bj * HALF) = pack8(acc[ai][bj][m][0] + b[bj][0], acc[ai][bj][m][1] + b[bj][1]); }
    }
};
}

struct Args {
    const float* x; const int* positions; const float* norm_mix_g; const float* w_in; const float* q_latent_g; const float* w_uq; const float* kv_latent_g; const float* w_ukv;
    const float* q_head_g; const float* k_head_g; const float* conv_dw_w; const float* conv_dw_b; const float* conv_ln_g; const float* conv_ln_b; const float* attn_out_g; const float* conv_out_g;
    const float* w_out; const float* norm_ffn_g; const float* router_w; const float* router_b; const float* w_gate_up; const float* b_gate_up; const float* w_down; const float* b_down;
    float* out; unsigned char* ws; int ph_lo, ph_hi, li, pad;
};

__device__ __forceinline__ void tr_item(const float* __restrict__ W, int ldw, int n0s, const float* __restrict__ gain, bf16* WT, int K, int n0d, int k0, LAS float* scr, int lane) {
    const int c = lane & 7;
    if (n0s < 0) {
#pragma unroll
        for (int j = 0; j < 4; ++j) { const int n = (lane >> 3) + 8 * j; *(GAS v4u*)(WT + (size_t)(n0d + n) * K + k0 + 8 * c) = (v4u){0u, 0u, 0u, 0u}; }
        return;
    }
    float v[32];
#pragma unroll
    for (int i = 0; i < 32; ++i) { const int kk = 2 * i + (lane >> 5); v[i] = W[(size_t)(k0 + kk) * ldw + n0s + (lane & 31)]; }
    if (gain) {
#pragma unroll
        for (int i = 0; i < 32; ++i) v[i] *= gain[k0 + 2 * i + (lane >> 5)];
    }
#pragma unroll
    for (int i = 0; i < 32; ++i) { const int kk = 2 * i + (lane >> 5); scr[kk * 33 + (lane & 31)] = v[i]; }
    LDS_WAIT(); asm volatile("" ::: "memory");
#pragma unroll
    for (int j = 0; j < 4; ++j) { const int n = (lane >> 3) + 8 * j; const LAS float* s = scr + (8 * c) * 33 + n;
        v4u o; o.x = pk2(s[0 * 33], s[1 * 33]); o.y = pk2(s[2 * 33], s[3 * 33]); o.z = pk2(s[4 * 33], s[5 * 33]); o.w = pk2(s[6 * 33], s[7 * 33]);
        *(GAS v4u*)(WT + (size_t)(n0d + n) * K + k0 + 8 * c) = o; }
    LDS_WAIT(); asm volatile("" ::: "memory");
}

__device__ __forceinline__ void tr_item8(const float* __restrict__ W, int ldw, int n0s, const float* __restrict__ gain, unsigned char* WT, int K, int n0d, int k0, LAS float* scr, int lane) {
    const int c = lane & 7;
#pragma unroll 1
    for (int hh = 0; hh < 2; ++hh) { const int kb = k0 + 64 * hh;
        float v[32];
#pragma unroll
        for (int i = 0; i < 32; ++i) { const int kk = 2 * i + (lane >> 5); v[i] = W[(size_t)(kb + kk) * ldw + n0s + (lane & 31)]; }
        if (gain) {
#pragma unroll
            for (int i = 0; i < 32; ++i) v[i] *= gain[kb + 2 * i + (lane >> 5)];
        }
#pragma unroll
        for (int i = 0; i < 32; ++i) { const int kk = 2 * i + (lane >> 5); scr[kk * 33 + (lane & 31)] = v[i] * 256.f; }
        LDS_WAIT(); asm volatile("" ::: "memory");
#pragma unroll
        for (int j = 0; j < 4; ++j) { const int n = (lane >> 3) + 8 * j; const LAS float* s = scr + (8 * c) * 33 + n;
            *(GAS v2u*)(WT + (size_t)(n0d + n) * K + kb + 8 * c) = pack8_fp8(s[0 * 33], s[1 * 33], s[2 * 33], s[3 * 33], s[4 * 33], s[5 * 33], s[6 * 33], s[7 * 33]); }
        LDS_WAIT(); asm volatile("" ::: "memory");
    }
}

__device__ __forceinline__ void p0_prologue(const Args& a, LAS unsigned char* lds, int vcu, int G, int wave, int lane, int tid) {
    unsigned char* ws = a.ws;
    LAS float* scr = (LAS float*)(lds + wave * 16384);
    const int gw = vcu * 8 + wave, NGW = G * 8;
    constexpr int I_IN = 16 * 56, I_UQ = 6 * 24, I_UKV = 2 * 32, I_OUT = 16 * 32, I_GU = 32 * 512, I_D = 32 * 256;
    constexpr int NITEMS = I_IN + I_UQ + I_UKV + I_OUT + I_GU + I_D;
    for (int it = gw; it < NITEMS; it += NGW) {
        int r = it;
        if (r < I_GU) {
            const int e = r >> 9, r2 = r & 511, nb = r2 & 63, kb = r2 >> 6, tn = nb >> 3, w = nb & 7;
            const int src = (w < 4) ? (128 * tn + 32 * w) : (1024 + 128 * tn + 32 * (w - 4));
            tr_item8(a.w_gate_up + (size_t)e * 1024 * 2048, 2048, src, a.norm_ffn_g, ws + WS_WGU8 + (size_t)e * 2048 * 1024, 1024, 32 * nb, 128 * kb, scr, lane); continue; }
        r -= I_GU;
        if (r < I_D) { const int e = r >> 8, r2 = r & 255, nb = r2 & 31, kb = r2 >> 5;
            tr_item8(a.w_down + (size_t)e * 1024 * 1024, 1024, 32 * nb, nullptr, ws + WS_WD8 + (size_t)e * 1024 * 1024, 1024, 32 * nb, 128 * kb, scr, lane); continue; }
        r -= I_D;
        if (r < I_IN) { const int nb = r % 56, kb = r / 56; int src;
            if (nb < 16) src = 32 * nb; else if (nb < 48) { const int tn = (nb - 16) >> 3, w = (nb - 16) & 7; src = (w < 4) ? (544 + 128 * tn + 32 * w) : (544 + 512 + 128 * tn + 32 * (w - 4)); } else if (nb == 48) src = 512; else src = -1;
            tr_item(a.w_in, INW, src, nullptr, (bf16*)(ws + WS_WIN), 1024, 32 * nb, 64 * kb, scr, lane); continue; }
        r -= I_IN;
        if (r < I_UQ) { const int nb = r % 24, kb = r / 24; tr_item(a.w_uq, 768, 32 * nb, a.q_latent_g, (bf16*)(ws + WS_WUQ), QL, 32 * nb, 64 * kb, scr, lane); continue; }
        r -= I_UQ;
        if (r < I_UKV) { const int nb = r % 32, kb = r / 32, tn = nb >> 3, w = nb & 7, bj = w >> 2, wc = w & 3; const int head = 2 * tn + (wc & 1), isv = wc >> 1;
            tr_item(a.w_ukv, 1024, head * 128 + isv * 64 + 32 * bj, a.kv_latent_g, (bf16*)(ws + WS_WUKV), KVL, 32 * nb, 64 * kb, scr, lane); continue; }
        r -= I_UKV;
        { const int nb = r % 32, kb = r / 32; tr_item(a.w_out, 1024, 32 * nb, nullptr, (bf16*)(ws + WS_WOUT), 1024, 32 * nb, 64 * kb, scr, lane); }
    }
    {
        f32x4 g[4];
#pragma unroll
        for (int j = 0; j < 4; ++j) g[j] = ((const f32x4*)a.norm_mix_g)[lane + 64 * j];
        bf16* H1 = (bf16*)(ws + WS_H1);
        for (int m = gw; m < T; m += NGW) {
            const GAS f32x4* xr = (const GAS f32x4*)(a.x + (size_t)m * D) + lane;
            f32x4 v[4]; float s = 0.f;
#pragma unroll
            for (int j = 0; j < 4; ++j) { v[j] = xr[64 * j]; s += (v[j].x * v[j].x + v[j].y * v[j].y) + (v[j].z * v[j].z + v[j].w * v[j].w); }
            const float rstd = __builtin_amdgcn_rsqf(wave_sum(s) * (1.f / D) + EPS);
            GAS v2u* o8 = (GAS v2u*)(H1 + (size_t)m * D) + lane;
#pragma unroll
            for (int j = 0; j < 4; ++j) { v2u w; w.x = pk2(v[j].x * rstd * g[j].x, v[j].y * rstd * g[j].y); w.y = pk2(v[j].z * rstd * g[j].z, v[j].w * rstd * g[j].w); o8[64 * j] = w; }
        }
    }
    {
        const int gt = vcu * 512 + tid, NT_ = G * 512;
        f32x2* cs = (f32x2*)(ws + WS_CS);
        for (int idx = gt; idx < T * 16; idx += NT_) {
            const int t = idx >> 4, i = idx & 15;
            const float p4[4] = {1.0f, 1.7782794100389228f, 3.1622776601683795f, 5.623413251903491f};
            float pw = p4[i & 3]; const int dec = i >> 2; pw *= (dec == 0 ? 1.f : dec == 1 ? 10.f : dec == 2 ? 100.f : 1000.f);
            const float inv = 1.0f / pw;
            const float ang = (float)a.positions[t] * inv;
            const double rev = (double)ang * 0.15915494309189535; const double fr = rev - __builtin_rint(rev);
            float sn, cn; sincospif((float)(2.0 * fr), &sn, &cn);
            cs[idx] = (f32x2){cn, sn};
        }
        bf16* RT = (bf16*)(ws + WS_RT);
        for (int idx = gt; idx < 1024 * 32; idx += NT_) {
            const int k = idx >> 5, e = idx & 31; const float v = a.norm_ffn_g[k] * a.router_w[idx];
            const unsigned hi = pk2(v, 0.f) & 0xffffu; const float lo = v - bflo(hi);
            const int s = k >> 5, kq = (k >> 3) & 3, j = k & 7; const int di = ((s * 4 + kq) * 32 + e) * 8 + j;
            RT[di] = (bf16)hi; RT[32768 + di] = (bf16)(pk2(lo, 0.f) & 0xffffu);
        }
    }
}

__device__ __forceinline__ void p2_thin(const Args& a, LAS unsigned char* lds, int vcu, int G, int wave, int lane, int tid) {
    unsigned char* ws = a.ws;
    LAS float* wl = (LAS float*)lds;
    for (int i = tid; i < 32 * 512 / 4; i += 512) ((LAS f32x4*)wl)[i] = (i < CK * 512 / 4) ? ((const f32x4*)a.conv_dw_w)[i] : (f32x4){0.f, 0.f, 0.f, 0.f};
    __syncthreads();
    const bf16* CQKV = (const bf16*)(ws + WS_CQKV); const bf16* Y = (const bf16*)(ws + WS_Y); const float* KPE = (const float*)(ws + WS_KPE);
    float* RSQ = (float*)(ws + WS_RSQ); float* RSKV = (float*)(ws + WS_RSKV); float* KSS = (float*)(ws + WS_KSS); float* KR = (float*)(ws + WS_KR);
    const f32x2* CS = (const f32x2*)(ws + WS_CS); bf16* MIX = (bf16*)(ws + WS_MIX);
    const int c0 = 8 * lane;
    float dwb[8], lng[8], lnb[8], cog[8];
#pragma unroll
    for (int i = 0; i < 8; ++i) { dwb[i] = a.conv_dw_b[c0 + i]; lng[i] = a.conv_ln_g[c0 + i]; lnb[i] = a.conv_ln_b[c0 + i]; cog[i] = a.conv_out_g[c0 + i]; }
    const float gk1 = a.k_head_g[64 + (lane & 15)], gk2 = a.k_head_g[80 + (lane & 15)];
    const int gw = vcu * 8 + wave, NGW = G * 8;
    for (int blk = gw; blk < T / 4; blk += NGW) {
        const int t0 = blk * 4, tb = t0 & (S - 1);
#pragma unroll
        for (int r = 0; r < 4; ++r) { const int row = t0 + r;
            const v4u w = *(const v4u*)(CQKV + (size_t)row * 512 + c0);
            float ss = 0.f;
#pragma unroll
            for (int i = 0; i < 4; ++i) { const float lo = bflo(w[i]), hi = bfhi(w[i]); ss += lo * lo + hi * hi; }
            const float sq = wave_sum(lane < 48 ? ss : 0.f), skv = wave_sum(lane >= 48 ? ss : 0.f);
            const float kv = (lane < 32) ? KPE[(size_t)row * 32 + lane] : 0.f;
            const float ks = wave_sum(kv * kv);
            const float x1 = gk1 * __shfl(kv, lane & 15), x2 = gk2 * __shfl(kv, 16 + (lane & 15));
            const f32x2 cs = CS[(size_t)row * 16 + (lane & 15)];
            if (lane < 16) KR[(size_t)row * 32 + lane] = x1 * cs.x - x2 * cs.y;
            else if (lane < 32) KR[(size_t)row * 32 + lane] = x2 * cs.x + x1 * cs.y;
            if (lane == 0) { RSQ[row] = __builtin_amdgcn_rsqf(sq * (1.f / QL) + EPS); RSKV[row] = __builtin_amdgcn_rsqf(skv * (1.f / KVL) + EPS); KSS[row] = ks; }
        }
        float acc[4][8];
#pragma unroll
        for (int r = 0; r < 4; ++r)
#pragma unroll
            for (int i = 0; i < 8; ++i) acc[r][i] = dwb[i];
        float win[4][8];
#define LOADROW(dst, q) do { v4u w_ = (v4u){0u, 0u, 0u, 0u}; if (tb + (q) >= 0) w_ = *(const v4u*)(Y + (size_t)(t0 + (q)) * 512 + c0); \
            _Pragma("unroll") for (int i_ = 0; i_ < 4; ++i_) { dst[2 * i_] = bflo(w_[i_]); dst[2 * i_ + 1] = bfhi(w_[i_]); } } while (0)
        LOADROW(win[0], -30); LOADROW(win[1], -29); LOADROW(win[2], -28);
#pragma unroll 1
        for (int jb = 0; jb < 32; jb += 4) {
#pragma unroll
            for (int jj = 0; jj < 4; ++jj) { const int j = jb + jj;
                if (j - 27 < 4) LOADROW(win[(jj + 3) & 3], j - 27);
                const f32x4 w0 = *(const LAS f32x4*)(wl + j * 512 + c0), w1 = *(const LAS f32x4*)(wl + j * 512 + c0 + 4);
#pragma unroll
                for (int r = 0; r < 4; ++r)
#pragma unroll
                    for (int i = 0; i < 8; ++i) acc[r][i] += (i < 4 ? w0[i] : w1[i - 4]) * win[(jj + r) & 3][i];
            }
            asm volatile("" ::: "memory");
        }
#undef LOADROW
#pragma unroll
        for (int r = 0; r < 4; ++r) {
            float s1 = 0.f;
#pragma unroll
            for (int i = 0; i < 8; ++i) s1 += acc[r][i];
            const float mean = wave_sum(s1) * (1.f / CW);
            float s2 = 0.f;
#pragma unroll
            for (int i = 0; i < 8; ++i) { acc[r][i] -= mean; s2 += acc[r][i] * acc[r][i]; }
            const float rstd = __builtin_amdgcn_rsqf(wave_sum(s2) * (1.f / CW) + EPS);
            float s3 = 0.f;
#pragma unroll
            for (int i = 0; i < 8; ++i) { const float z = acc[r][i] * rstd * lng[i] + lnb[i]; const float sg = z * sigmoidf_(z); acc[r][i] = sg; s3 += sg * sg; }
            const float r3 = __builtin_amdgcn_rsqf(wave_sum(s3) * (1.f / CW) + EPS);
            v4u o;
#pragma unroll
            for (int i = 0; i < 4; ++i) o[i] = pk2(acc[r][2 * i] * r3 * cog[2 * i], acc[r][2 * i + 1] * r3 * cog[2 * i + 1]);
            *(v4u*)(MIX + (size_t)(t0 + r) * 1024 + 512 + c0) = o;
        }
    }
}

namespace at {
constexpr int KSLOT = 12288, VSLOT = 8192, NSLOT = 3;
constexpr int L_K = 0, L_V = NSLOT * KSLOT, L_WS = L_V + NSLOT * VSLOT, L_OST = L_WS + 8 * 64 * 4, L_END = L_OST + 8 * 4096;
static_assert(L_END <= RING_BYTES, "attention LDS");
__device__ __forceinline__ int crow(int r, int hi) { return (r & 3) + 8 * (r >> 2) + 4 * hi; }
__device__ __forceinline__ void glds16(const void* gsrc, unsigned lds_dst) { unsigned keep;
    asm volatile("s_mov_b32 %0, m0\n\ts_mov_b32 m0, %2\n\ts_nop 0\n\tglobal_load_lds_dwordx4 %1, off\n\ts_mov_b32 m0, %0" : "=&s"(keep) : "v"(gsrc), "s"(lds_dst) : "memory"); }
typedef short v4i16_t __attribute__((ext_vector_type(4)));
__device__ __forceinline__ s16x4 vtr(const LAS char* p) { return __builtin_bit_cast(s16x4, __builtin_amdgcn_ds_read_tr16_b64_v4i16((LAS v4i16_t*)p)); }

__device__ __forceinline__ void attn_unit(const Args& a, int b, int h, int qb, LAS unsigned char* shm3) {
    unsigned char* ws = a.ws;
    const bf16* QRAW = (const bf16*)(ws + WS_QRAW); const bf16* KF = (const bf16*)(ws + WS_KF); const bf16* VF = (const bf16*)(ws + WS_VF); bf16* AO = (bf16*)(ws + WS_AO);
    const float* RSQ = (const float*)(ws + WS_RSQ); const f32x2* CS = (const f32x2*)(ws + WS_CS);
    const int tid = threadIdx.x, lane = tid & 63, r32 = lane & 31, hi = lane >> 5; const int wid = __builtin_amdgcn_readfirstlane(tid >> 6);
    const long rowbase = (long)b * S; const int q0 = qb * 256;
    const int NT = 4 * qb + 4, my_nt = 4 * qb + (wid >> 1) + 1;
    const long myrow = rowbase + q0 + wid * 32 + r32;
    const unsigned lds0 = (unsigned)(uintptr_t)shm3;
    bf16x8 qr[6]; f32x16 negm;
    {
        const bf16* qp = QRAW + myrow * 768 + h * 96 + 8 * hi;
        float f[6][8]; float ss = 0.f;
#pragma unroll
        for (int d0 = 0; d0 < 6; ++d0) { const v4u w = *(const v4u*)(qp + 16 * d0);
#pragma unroll
            for (int i = 0; i < 4; ++i) { f[d0][2 * i] = bflo(w[i]); f[d0][2 * i + 1] = bfhi(w[i]); ss += f[d0][2 * i] * f[d0][2 * i] + f[d0][2 * i + 1] * f[d0][2 * i + 1]; } }
        ss = swap_sum(ss);
        const float rq = RSQ[myrow];
        const float rn = rq * __builtin_amdgcn_rsqf(rq * rq * ss * (1.f / 96.f) + EPS);
#pragma unroll
        for (int d0 = 0; d0 < 6; ++d0) { const f32x4 g0 = *(const f32x4*)(a.q_head_g + 16 * d0 + 8 * hi), g1 = *(const f32x4*)(a.q_head_g + 16 * d0 + 8 * hi + 4);
#pragma unroll
            for (int i = 0; i < 4; ++i) { f[d0][i] *= rn * g0[i]; f[d0][4 + i] *= rn * g1[i]; } }
        const f32x2* csr = CS + myrow * 16 + 8 * hi;
#pragma unroll
        for (int j = 0; j < 8; ++j) { const f32x2 cs = csr[j]; const float x1 = f[4][j], x2 = f[5][j]; f[4][j] = x1 * cs.x - x2 * cs.y; f[5][j] = x2 * cs.x + x1 * cs.y; }
        float n2 = 0.f;
#pragma unroll
        for (int d0 = 0; d0 < 6; ++d0)
#pragma unroll
            for (int j = 0; j < 8; ++j) n2 += f[d0][j] * f[d0][j];
        n2 = swap_sum(n2);
        float gm_ = fabsf(a.k_head_g[lane]); if (lane < 32) gm_ = fmaxf(gm_, fabsf(a.k_head_g[64 + lane])); gm_ = wave_max(gm_);
        const float Mq = __builtin_sqrtf(n2) * gm_ * (9.797959f * 1.02f) * C2;
#pragma unroll
        for (int d0 = 0; d0 < 6; ++d0) { v4u w;
#pragma unroll
            for (int i = 0; i < 4; ++i) w[i] = pk2(f[d0][2 * i] * C2, f[d0][2 * i + 1] * C2);
            qr[d0] = __builtin_bit_cast(bf16x8, w); }
#pragma unroll
        for (int r = 0; r < 16; ++r) negm[r] = -Mq;
    }
    VM_WAIT();
    __builtin_amdgcn_sched_barrier(0);
    const bf16* ksrc = KF + (rowbase + lane) * 768 + h * 96 + 8 * wid;
    const bf16* vsrc = VF + (rowbase + 16 * (wid & 3) + (lane >> 2)) * 512 + h * 64 + (wid >> 2) * 32 + (lane & 3) * 8;
    const unsigned kdst = lds0 + L_K + wid * 1024, vdst = lds0 + L_V + wid * 1024;
#define DMA_TILE(t, sl) do { const bf16* ks_ = ksrc + (long)(t) * 64 * 768; \
        glds16(ks_, (unsigned)__builtin_amdgcn_readfirstlane(kdst + (sl) * KSLOT)); \
        if (wid < 4) glds16(ks_ + 64, (unsigned)__builtin_amdgcn_readfirstlane(kdst + (sl) * KSLOT + 8192)); \
        glds16(vsrc + (long)(t) * 64 * 512, (unsigned)__builtin_amdgcn_readfirstlane(vdst + (sl) * VSLOT)); } while (0)
    DMA_TILE(0, 0); DMA_TILE(1, 1);
    float lsum = 0.f; f32x16 o0 = {}, o1 = {};
    const LAS char* kp0 = (const LAS char*)shm3 + L_K + hi * 1024 + r32 * 16;
    const LAS char* vp0 = (const LAS char*)shm3 + L_V + ((lane >> 4) & 1) * 32 + (lane & 3) * 8 + (4 * hi + ((lane & 15) >> 2)) * 64;
    int slot = 0;
    for (int j = 0; j < NT; ++j) {
        if (j + 1 < NT) { if (wid < 4) asm volatile("s_waitcnt vmcnt(3)" ::: "memory"); else asm volatile("s_waitcnt vmcnt(2)" ::: "memory"); }
        else asm volatile("s_waitcnt vmcnt(0)" ::: "memory");
        asm volatile("s_waitcnt lgkmcnt(0)\n\ts_barrier" ::: "memory");
        if (j + 2 < NT) { const int s2 = (slot >= 1) ? slot - 1 : 2; DMA_TILE(j + 2, s2); }
        if (j < my_nt) {
            const LAS char* kp = kp0 + slot * KSLOT;
            f32x16 p0 = negm, p1 = negm;
#pragma unroll
            for (int d0 = 0; d0 < 6; ++d0) {
                const bf16x8 k0 = *(const LAS bf16x8*)(kp + d0 * 2048), k1 = *(const LAS bf16x8*)(kp + d0 * 2048 + 512);
                p0 = __builtin_amdgcn_mfma_f32_32x32x16_bf16(k0, qr[d0], p0, 0, 0, 0);
                p1 = __builtin_amdgcn_mfma_f32_32x32x16_bf16(k1, qr[d0], p1, 0, 0, 0);
            }
            float sacc = 0.f;
#pragma unroll
            for (int r = 0; r < 16; ++r) { p0[r] = fast_exp2(p0[r]); p1[r] = fast_exp2(p1[r]); sacc += p0[r] + p1[r]; }
            lsum += sacc;
            v4u pw[4];
#pragma unroll
            for (int i = 0; i < 4; ++i) { pw[0][i] = pk2(p0[2 * i], p0[2 * i + 1]); pw[1][i] = pk2(p0[8 + 2 * i], p0[9 + 2 * i]); pw[2][i] = pk2(p1[2 * i], p1[2 * i + 1]); pw[3][i] = pk2(p1[8 + 2 * i], p1[9 + 2 * i]); }
            const LAS char* vp = vp0 + slot * VSLOT;
#pragma unroll
            for (int ks = 0; ks < 4; ++ks) {
                const s16x4 l0 = vtr(vp + ks * 1024), h0 = vtr(vp + ks * 1024 + 512), l1 = vtr(vp + 4096 + ks * 1024), h1 = vtr(vp + 4096 + ks * 1024 + 512);
                const bf16x8 v0 = (bf16x8){l0[0], l0[1], l0[2], l0[3], h0[0], h0[1], h0[2], h0[3]}, v1 = (bf16x8){l1[0], l1[1], l1[2], l1[3], h1[0], h1[1], h1[2], h1[3]};
                const bf16x8 pa = __builtin_bit_cast(bf16x8, pw[ks]);
                o0 = __builtin_amdgcn_mfma_f32_32x32x16_bf16(pa, v0, o0, 0, 0, 0);
                o1 = __builtin_amdgcn_mfma_f32_32x32x16_bf16(pa, v1, o1, 0, 0, 0);
            }
        }
        slot = (slot == 2) ? 0 : slot + 1;
    }
#undef DMA_TILE
    lsum = swap_sum(lsum);
    LAS float* wsf = (LAS float*)(shm3 + L_WS) + wid * 64;
    if (hi == 0) wsf[r32] = lsum;
    LDS_WAIT();
    LAS bf16* stg = (LAS bf16*)(shm3 + L_OST) + wid * 2048;
#pragma unroll
    for (int r = 0; r < 16; ++r) { const int orow = crow(r, hi); const float rl = __builtin_amdgcn_rcpf(wsf[orow]);
        stg[orow * 64 + r32] = (bf16)(pk2(o0[r] * rl, 0.f) & 0xffffu); stg[orow * 64 + 32 + r32] = (bf16)(pk2(o1[r] * rl, 0.f) & 0xffffu); }
    LDS_WAIT();
    bf16* Ow = AO + (rowbase + q0 + wid * 32) * 512 + h * 64;
#pragma unroll
    for (int i = 0; i < 4; ++i) { const int row = i * 8 + (lane >> 3), ch = lane & 7; const v4u v = *(const LAS v4u*)(stg + row * 64 + ch * 8); *(v4u*)(Ow + (long)row * 512 + ch * 8) = v; }
    asm volatile("s_waitcnt lgkmcnt(0)\n\ts_barrier" ::: "memory");
}
}

__device__ __forceinline__ void p5_attn_norm(const Args& a, int vcu, int G, int wave, int lane) {
    const bf16* AO = (const bf16*)(a.ws + WS_AO); bf16* MIX = (bf16*)(a.ws + WS_MIX);
    const int c0 = 8 * lane; float g[8];
#pragma unroll
    for (int i = 0; i < 8; ++i) g[i] = a.attn_out_g[c0 + i];
    const int gw = vcu * 8 + wave, NGW = G * 8;
    for (int row = gw; row < T; row += NGW) {
        const v4u w = *(const v4u*)(AO + (size_t)row * 512 + c0);
        float f[8]; float ss = 0.f;
#pragma unroll
        for (int i = 0; i < 4; ++i) { f[2 * i] = bflo(w[i]); f[2 * i + 1] = bfhi(w[i]); ss += f[2 * i] * f[2 * i] + f[2 * i + 1] * f[2 * i + 1]; }
        const float r = __builtin_amdgcn_rsqf(wave_sum(ss) * (1.f / AW) + EPS);
        v4u o;
#pragma unroll
        for (int i = 0; i < 4; ++i) o[i] = pk2(f[2 * i] * r * g[2 * i], f[2 * i + 1] * r * g[2 * i + 1]);
        *(v4u*)(MIX + (size_t)row * 1024 + c0) = o;
    }
}

__device__ __forceinline__ void p7_router(const Args& a, LAS unsigned char* lds, int vcu, int G, int wave, int lane, int tid) {
    unsigned char* ws = a.ws;
    for (int i = tid; i < 8192; i += 512) ((LAS v4u*)lds)[i] = ((const v4u*)(ws + WS_RT))[i];
    LAS int* LCNT = (LAS int*)(lds + LCNT_OFF); LAS int* LBASE = (LAS int*)(lds + LBASE_OFF);
    gu32* gcnt = (gu32*)(ws + WS_CTL) + CW_CNT;
    int* POS = (int*)(ws + WS_POS); float* GWt = (float*)(ws + WS_GW); int* TOKL = (int*)(ws + WS_TOKL); float* RSL = (float*)(ws + WS_RSL);
    const int fr = lane & 15, kq = lane >> 4;
    for (int rnd = vcu; rnd < T / 128; rnd += G) {
        if (tid < 32) LCNT[tid] = 0;
        __syncthreads();
        const int t = rnd * 128 + wave * 16 + fr;
        const float* xr = a.out + (size_t)t * D + 8 * kq;
        f32x4 d0 = {0.f, 0.f, 0.f, 0.f}, d1 = {0.f, 0.f, 0.f, 0.f}; float ss = 0.f;
        const LAS char* rp = (const LAS char*)lds + (kq * 32 + fr) * 16;
#pragma unroll 4
        for (int s = 0; s < 32; ++s) {
            const f32x4 xa = *(const f32x4*)(xr + 32 * s), xb = *(const f32x4*)(xr + 32 * s + 4);
            ss += (xa[0] * xa[0] + xa[1] * xa[1]) + (xa[2] * xa[2] + xa[3] * xa[3]) + (xb[0] * xb[0] + xb[1] * xb[1]) + (xb[2] * xb[2] + xb[3] * xb[3]);
            v4u hw, lw;
            hw[0] = pk2(xa[0], xa[1]); hw[1] = pk2(xa[2], xa[3]); hw[2] = pk2(xb[0], xb[1]); hw[3] = pk2(xb[2], xb[3]);
            lw[0] = pk2(xa[0] - bflo(hw[0]), xa[1] - bfhi(hw[0])); lw[1] = pk2(xa[2] - bflo(hw[1]), xa[3] - bfhi(hw[1]));
            lw[2] = pk2(xb[0] - bflo(hw[2]), xb[1] - bfhi(hw[2])); lw[3] = pk2(xb[2] - bflo(hw[3]), xb[3] - bfhi(hw[3]));
            const bf16x8 xh = __builtin_bit_cast(bf16x8, hw), xl = __builtin_bit_cast(bf16x8, lw);
            const bf16x8 rh0 = *(const LAS bf16x8*)(rp + s * 2048), rh1 = *(const LAS bf16x8*)(rp + s * 2048 + 256);
            const bf16x8 rl0 = *(const LAS bf16x8*)(rp + 65536 + s * 2048), rl1 = *(const LAS bf16x8*)(rp + 65536 + s * 2048 + 256);
            d0 = __builtin_amdgcn_mfma_f32_16x16x32_bf16(rh0, xh, d0, 0, 0, 0); d1 = __builtin_amdgcn_mfma_f32_16x16x32_bf16(rh1, xh, d1, 0, 0, 0);
            d0 = __builtin_amdgcn_mfma_f32_16x16x32_bf16(rl0, xh, d0, 0, 0, 0); d1 = __builtin_amdgcn_mfma_f32_16x16x32_bf16(rl1, xh, d1, 0, 0, 0);
            d0 = __builtin_amdgcn_mfma_f32_16x16x32_bf16(rh0, xl, d0, 0, 0, 0); d1 = __builtin_amdgcn_mfma_f32_16x16x32_bf16(rh1, xl, d1, 0, 0, 0);
        }
        ss += __shfl_xor(ss, 16); ss += __shfl_xor(ss, 32);
        const float rstd = __builtin_amdgcn_rsqf(ss * (1.f / D) + EPS);
        float lg[32];
#pragma unroll
        for (int q = 0; q < 4; ++q)
#pragma unroll
            for (int r = 0; r < 4; ++r) { lg[4 * q + r] = __shfl(d0[r], fr + 16 * q) * rstd + a.router_b[4 * q + r]; lg[16 + 4 * q + r] = __shfl(d1[r], fr + 16 * q) * rstd + a.router_b[16 + 4 * q + r]; }
        unsigned taken = 0u; float tv[4]; int ti[4];
#pragma unroll
        for (int k = 0; k < 4; ++k) { float best = -INFINITY; int bi = 0;
#pragma unroll
            for (int e = 0; e < 32; ++e) { const bool ok = !((taken >> e) & 1u) && (lg[e] > best); best = ok ? lg[e] : best; bi = ok ? e : bi; }
            tv[k] = best; ti[k] = bi; taken |= 1u << bi; }
        float ex[4], es = 0.f;
#pragma unroll
        for (int k = 0; k < 4; ++k) { ex[k] = __expf(tv[k] - tv[0]); es += ex[k]; }
        const float ies = 1.f / es;
        int rank[4];
        if (kq == 0) {
#pragma unroll
            for (int k = 0; k < 4; ++k) rank[k] = __hip_atomic_fetch_add(LCNT + ti[k], 1, __ATOMIC_RELAXED, __HIP_MEMORY_SCOPE_WORKGROUP);
        }
        __syncthreads();
        if (tid < 32) { const int c = LCNT[tid]; int base = 0; if (c > 0) base = (int)__hip_atomic_fetch_add(gcnt + 64 * tid, (unsigned)c, __ATOMIC_RELAXED, __HIP_MEMORY_SCOPE_AGENT); LBASE[tid] = base; }
        __syncthreads();
        if (kq == 0) {
#pragma unroll
            for (int k = 0; k < 4; ++k) { const int e = ti[k]; const int sl = LBASE[e] + rank[k];
                TOKL[(size_t)e * T + sl] = t; RSL[(size_t)e * T + sl] = rstd; POS[t * 4 + k] = (e << 16) | sl; GWt[t * 4 + k] = ex[k] * ies; }
        }
        __syncthreads();
    }
}

__device__ __forceinline__ void moe_tables(const Args& a, LAS unsigned char* lds, int tid) {
    LAS int* TS = (LAS int*)(lds + TS_OFF); LAS int* EC = (LAS int*)(lds + ECNT_OFF);
    const gu32* gcnt = (const gu32*)(a.ws + WS_CTL) + CW_CNT;
    if (tid == 0) { int acc = 0; for (int e = 0; e < NE; ++e) { const int c = (int)__hip_atomic_load(gcnt + 64 * e, __ATOMIC_RELAXED, __HIP_MEMORY_SCOPE_AGENT); EC[e] = c; TS[e] = acc; acc += (c + 255) >> 8; } TS[NE] = acc; }
    __syncthreads();
}

__device__ __forceinline__ void p10_combine(const Args& a, LAS unsigned char* lds, int vcu, int G, int wave, int lane) {
    const LAS int* TS = (const LAS int*)(lds + TS_OFF);
    const int* POS = (const int*)(a.ws + WS_POS); const float* GWt = (const float*)(a.ws + WS_GW); const bf16* YS = (const bf16*)(a.ws + WS_YS);
    const int gw = vcu * 8 + wave, NGW = G * 8;
    for (int t = gw; t < T; t += NGW) {
        float* orow = a.out + (size_t)t * D;
        f32x4 v[2][2];
#pragma unroll
        for (int j = 0; j < 2; ++j) { v[j][0] = *(const f32x4*)(orow + 512 * j + 8 * lane); v[j][1] = *(const f32x4*)(orow + 512 * j + 8 * lane + 4); }
#pragma unroll
        for (int k = 0; k < 4; ++k) { const int p = POS[t * 4 + k]; const float w = GWt[t * 4 + k]; const int e = p >> 16, sl = p & 0xffff;
            const bf16* yr = YS + ((size_t)TS[e] * 256 + sl) * 1024;
#pragma unroll
            for (int j = 0; j < 2; ++j) { const v4u y = *(const v4u*)(yr + 512 * j + 8 * lane);
                v[j][0][0] += w * bflo(y[0]); v[j][0][1] += w * bfhi(y[0]); v[j][0][2] += w * bflo(y[1]); v[j][0][3] += w * bfhi(y[1]);
                v[j][1][0] += w * bflo(y[2]); v[j][1][1] += w * bfhi(y[2]); v[j][1][2] += w * bflo(y[3]); v[j][1][3] += w * bfhi(y[3]); } }
#pragma unroll
        for (int j = 0; j < 2; ++j) { *(f32x4*)(orow + 512 * j + 8 * lane) = v[j][0]; *(f32x4*)(orow + 512 * j + 8 * lane + 4) = v[j][1]; }
    }
}

__global__ void __launch_bounds__(512, 2) mk_fwd(Args args) {
    extern __shared__ __attribute__((aligned(16))) unsigned char lds_raw[];
    LAS unsigned char* lds = (LAS unsigned char*)lds_raw;
    const int tid = threadIdx.x, lane = tid & 63, wave = __builtin_amdgcn_readfirstlane(tid >> 6);
    const int G = gridDim.x; const int bx = blockIdx.x; const int vcu = (G % 8 == 0) ? (bx % 8) * (G / 8) + bx / 8 : bx;
    unsigned char* ws = args.ws;
    for (int u = tid; u < (LDS_BYTES - MISC_OFF) / 4; u += 512) ((LAS unsigned*)(lds + MISC_OFF))[u] = 0u;
    __syncthreads();
    gu32* ctl = (gu32*)(ws + WS_CTL);
#if MK_PER_PHASE
#define GRID_BAR() do { } while (0)
#else
    XcdBarrier bar = xcd_barrier_post((unsigned*)ctl + CW_BAR + args.li * XCD_BAR_WORDS, (volatile LAS unsigned*)(lds + MISC_OFF));
#define GRID_BAR() xcd_barrier(bar)
#endif
    const int lo = args.ph_lo, hi = args.ph_hi;
#ifdef PROBE_VAR
    const int PV_SKIP = (args.li == 1) ? ((PROBE_VAR & 1) | ((PROBE_VAR & 4) >> 1)) : 0, PV_FIX = (args.li == 1 && (PROBE_VAR & 2)) ? 1 : 0;
#else
    constexpr int PV_SKIP = 0, PV_FIX = 0;
#endif
#define IN(k) (lo <= (k) && (k) < hi)
#define BOTH(k) (IN(k) && IN((k) + 1))

    if (IN(0)) { p0_prologue(args, lds, vcu, G, wave, lane, tid); if (BOTH(0)) GRID_BAR(); }

    if (IN(1)) {
        gm::DenseSched Sd; Sd.init(ws + WS_H1, ws + WS_WIN, T, NIN1, 1024, 1024, G, bx);
        gm::EpiIn E{(bf16*)(ws + WS_CQKV), (bf16*)(ws + WS_Y), (float*)(ws + WS_KPE)};
        gm::gemm_phase<false>(lds, Sd, E, PV_SKIP);
        if (BOTH(1)) GRID_BAR();
    }
    if (IN(2)) { p2_thin(args, lds, vcu, G, wave, lane, tid); if (BOTH(2)) GRID_BAR(); }

    if (IN(3)) {
        { gm::DenseSched Sd; Sd.init(ws + WS_CQKV, ws + WS_WUQ, T, 768, QL, 512, G, bx);
          gm::EpiPlain E{(bf16*)(ws + WS_QRAW), 768};
          gm::gemm_phase<false>(lds, Sd, E, PV_SKIP); }
        { gm::DenseSched Sd; Sd.init(ws + WS_CQKV + QL * 2, ws + WS_WUKV, T, 1024, KVL, 512, G, bx);
          gm::EpiKV E{(bf16*)(ws + WS_KF), (bf16*)(ws + WS_VF), (const float*)(ws + WS_RSKV), (const float*)(ws + WS_KSS), (const float*)(ws + WS_KR), args.k_head_g};
          gm::gemm_phase<false>(lds, Sd, E, PV_SKIP); }
        if (BOTH(3)) GRID_BAR();
    }
    if (IN(4)) {
        for (int v = vcu; v < 256; v += G) {
            const int bh = v >> 2, j = v & 3;
            for (int i = 0; i < 4; ++i) { const int qb = (i == 0) ? j : (i == 1) ? 15 - j : (i == 2) ? 4 + j : 11 - j; at::attn_unit(args, bh >> 3, bh & 7, qb, lds); }
        }
        if (BOTH(4)) GRID_BAR();
    }
    if (IN(5)) { p5_attn_norm(args, vcu, G, wave, lane); if (BOTH(5)) GRID_BAR(); }

    if (IN(6)) {
        gm::DenseSched Sd; Sd.init(ws + WS_MIX, ws + WS_WOUT, T, 1024, 1024, 1024, G, bx);
        gm::EpiX1 E{args.x, args.out, ws + WS_X1Q};
        gm::gemm_phase<false>(lds, Sd, E, PV_SKIP);
        if (BOTH(6)) GRID_BAR();
    }
    if (IN(7)) { p7_router(args, lds, vcu, G, wave, lane, tid); if (BOTH(7)) GRID_BAR(); }

    if (IN(8) || IN(9) || IN(10)) moe_tables(args, lds, tid);
    if (IN(8)) {
        gm::MoeSched<true> Sm{(const char*)(ws + WS_X1Q), (const char*)(ws + WS_WGU8), 512, 512, 2048, 8, (const int*)(ws + WS_TOKL), (const LAS int*)(lds + TS_OFF), (const LAS int*)(lds + ECNT_OFF), 0, 0, 0};
        Sm.range(vcu, G);
        gm::EpiGU E{ws + WS_ACT8, args.b_gate_up, (const float*)(ws + WS_RSL), (const LAS int*)(lds + ECNT_OFF)};
        gm::gemm_phase<true>(lds, Sm, E, PV_SKIP);
        if (BOTH(8)) GRID_BAR();
    }
    if (IN(9)) {
        gm::MoeSched<false> Sm{(const char*)(ws + WS_ACT8), (const char*)(ws + WS_WD8), 512, 512, 1024, 4, nullptr, (const LAS int*)(lds + TS_OFF), (const LAS int*)(lds + ECNT_OFF), 0, 0, PV_FIX};
        Sm.range(vcu, G);
        gm::EpiDown E{(bf16*)(ws + WS_YS), args.b_down};
        gm::gemm_phase<true>(lds, Sm, E, PV_SKIP);
        if (BOTH(9)) GRID_BAR();
    }
    if (IN(10)) { p10_combine(args, lds, vcu, G, wave, lane); }
#undef IN
#undef BOTH
}

extern "C" void kernel_launch(void* const* d_in, const int* in_sizes, int n_in, void* d_out, int out_size, void* d_ws, size_t ws_size, hipStream_t stream) {
    static int grid = 0;
    if (grid == 0) {
        if (n_in != 24 || in_sizes[0] != T * D || out_size != T * D || ws_size < WS_END) { fprintf(stderr, "kernel_launch: unexpected shapes (n_in %d, in0 %d, out %d, ws %zu < %zu)\n", n_in, n_in > 0 ? in_sizes[0] : -1, out_size, ws_size, (size_t)WS_END); grid = -1; return; }
        int dev = 0, cus = 0, per_cu = 0;
        if (hipGetDevice(&dev) != hipSuccess || hipDeviceGetAttribute(&cus, hipDeviceAttributeMultiprocessorCount, dev) != hipSuccess) { fprintf(stderr, "kernel_launch: device query failed\n"); grid = -1; return; }
        if (hipFuncSetAttribute((const void*)mk_fwd, hipFuncAttributeMaxDynamicSharedMemorySize, LDS_BYTES) != hipSuccess) { fprintf(stderr, "kernel_launch: hipFuncSetAttribute failed\n"); grid = -1; return; }
        if (hipOccupancyMaxActiveBlocksPerMultiprocessor(&per_cu, (const void*)mk_fwd, 512, LDS_BYTES) != hipSuccess || per_cu < 1) fprintf(stderr, "kernel_launch: occupancy query says %d\n", per_cu);
        (void)hipGetLastError();
        grid = cus;
    }
    if (grid < 0) return;
    if (hipMemsetAsync((char*)d_ws + WS_CTL, 0, CTL_ZERO_BYTES, stream) != hipSuccess) { fprintf(stderr, "kernel_launch: memset failed\n"); return; }
    Args a{};
    a.x = (const float*)d_in[0]; a.positions = (const int*)d_in[1]; a.norm_mix_g = (const float*)d_in[2]; a.w_in = (const float*)d_in[3]; a.q_latent_g = (const float*)d_in[4]; a.w_uq = (const float*)d_in[5];
    a.kv_latent_g = (const float*)d_in[6]; a.w_ukv = (const float*)d_in[7]; a.q_head_g = (const float*)d_in[8]; a.k_head_g = (const float*)d_in[9]; a.conv_dw_w = (const float*)d_in[10]; a.conv_dw_b = (const float*)d_in[11];
    a.conv_ln_g = (const float*)d_in[12]; a.conv_ln_b = (const float*)d_in[13]; a.attn_out_g = (const float*)d_in[14]; a.conv_out_g = (const float*)d_in[15]; a.w_out = (const float*)d_in[16]; a.norm_ffn_g = (const float*)d_in[17];
    a.router_w = (const float*)d_in[18]; a.router_b = (const float*)d_in[19]; a.w_gate_up = (const float*)d_in[20]; a.b_gate_up = (const float*)d_in[21]; a.w_down = (const float*)d_in[22]; a.b_down = (const float*)d_in[23];
    a.out = (float*)d_out; a.ws = (unsigned char*)d_ws;
#if MK_PER_PHASE
    for (int p = 0; p < NPH; ++p) { a.ph_lo = p; a.ph_hi = p + 1; hipLaunchKernelGGL(mk_fwd, dim3(grid), dim3(512), LDS_BYTES, stream, a); }
#elif defined(PROBE_DUP)
    { const int k = PROBE_DUP; const int los[3] = {0, k, k + 1}, his[3] = {k + 1, k + 1, NPH};
      for (int l = 0; l < 3; ++l) { if (los[l] >= his[l]) continue; a.ph_lo = los[l]; a.ph_hi = his[l]; a.li = l; hipLaunchKernelGGL(mk_fwd, dim3(grid), dim3(512), LDS_BYTES, stream, a); } }
#else
    a.ph_lo = 0; a.ph_hi = NPH; hipLaunchKernelGGL(mk_fwd, dim3(grid), dim3(512), LDS_BYTES, stream, a);
#endif
    const hipError_t le = hipPeekAtLastError();
    if (le != hipSuccess) fprintf(stderr, "kernel_launch: launch failed: %s\n", hipGetErrorName(le));
}
```
